# Optimizing an MI355X kernel written in HIP

```python
import jax, jax.numpy as jnp
from jax import lax
import numpy as np

D_MODEL = 1024
BATCH = 8
SEQ = 4096
DEPTH = 2

ATT_HEADS = 8
ATT_KV_HEADS = 2
ATT_HEAD_DIM = 64
ATT_GROUP = ATT_HEADS // ATT_KV_HEADS
WINDOW = 128
ATT_BLOCK = 128
ROPE_DIM = ATT_HEAD_DIM // 4
ROPE_THETA = 500000.0
M_HEADS = 4
M_QK_DIM = 64
M_V_DIM = 128
M_CHUNK = 64
D_FF = 4 * D_MODEL
EPS = 1e-6

ATT_Q_W = ATT_HEADS * ATT_HEAD_DIM
ATT_KV_W = ATT_KV_HEADS * ATT_HEAD_DIM
M_QK_W = M_HEADS * M_QK_DIM
M_V_W = M_HEADS * M_V_DIM
IN_WIDTHS = (ATT_Q_W, ATT_KV_W, ATT_KV_W, M_QK_W, M_QK_W, M_V_W, M_V_W, 2 * M_HEADS, 2 * D_MODEL)
D_IN = sum(IN_WIDTHS)

kernel_name = "hybrid_swa_mlstm_gated_block"


def rmsnorm(x, gain):
    x32 = x.astype(jnp.float32)
    inv = lax.rsqrt(jnp.mean(x32 * x32, axis=-1, keepdims=True) + EPS)
    return (x32 * inv).astype(x.dtype) * gain


def rope_tables(seq_len):
    pos = jnp.arange(seq_len, dtype=jnp.float32)
    inv_freq = ROPE_THETA ** (-jnp.arange(0, ROPE_DIM, 2, dtype=jnp.float32) / ROPE_DIM)
    ang = pos[:, None] * inv_freq[None, :]
    return jnp.cos(ang), jnp.sin(ang)


def partial_rope(x, cos, sin):
    half = ROPE_DIM // 2
    x1 = x[..., :half].astype(jnp.float32)
    x2 = x[..., half:ROPE_DIM].astype(jnp.float32)
    c = cos[None, :, None, :]
    s = sin[None, :, None, :]
    return jnp.concatenate([(x1 * c - x2 * s).astype(x.dtype),
                            (x2 * c + x1 * s).astype(x.dtype),
                            x[..., ROPE_DIM:]], axis=-1)


def sliding_window_attention(q, k, v, sinks):
    B, S, _, hd = q.shape
    nb = S // ATT_BLOCK
    qb = q.reshape(B, nb, ATT_BLOCK, ATT_KV_HEADS, ATT_GROUP, hd)

    def with_prev(t):
        tb = t.reshape(B, nb, ATT_BLOCK, ATT_KV_HEADS, hd)
        prev = jnp.pad(tb, ((0, 0), (1, 0), (0, 0), (0, 0), (0, 0)))[:, :-1]
        return jnp.concatenate([prev, tb], axis=2)

    kb, vb = with_prev(k), with_prev(v)
    scores = jnp.einsum('bnqhgd,bnkhd->bnhgqk', qb, kb).astype(jnp.float32) * (hd ** -0.5)
    blk = jnp.arange(nb)[:, None, None]
    qpos = blk * ATT_BLOCK + jnp.arange(ATT_BLOCK)[None, :, None]
    kpos = (blk - 1) * ATT_BLOCK + jnp.arange(2 * ATT_BLOCK)[None, None, :]
    valid = (kpos >= 0) & (kpos <= qpos) & (qpos - kpos < WINDOW)
    scores = jnp.where(valid[None, :, None, None], scores, -jnp.inf)
    sink = sinks.astype(jnp.float32).reshape(ATT_KV_HEADS, ATT_GROUP)[None, None, :, :, None, None]
    m = jnp.maximum(jnp.max(scores, axis=-1, keepdims=True), sink)
    p = jnp.exp(scores - m)
    probs = (p / (jnp.sum(p, axis=-1, keepdims=True) + jnp.exp(sink - m))).astype(v.dtype)
    out = jnp.einsum('bnhgqk,bnkhd->bnqhgd', probs, vb)
    return out.reshape(B, S, ATT_HEADS * hd)


def mlstm_chunkwise(q, k, v, i_pre, f_pre):
    f32 = jnp.float32
    B, S, H, dk = q.shape
    dv = v.shape[-1]
    L = M_CHUNK
    nc = S // L

    def chunks(t):
        return t.astype(f32).reshape(B, nc, L, H, -1).transpose(0, 1, 3, 2, 4)

    q = chunks(q) * (dk ** -0.5)
    k = chunks(k)
    v = chunks(v)
    log_f = jax.nn.log_sigmoid(f_pre.astype(f32)).reshape(B, nc, L, H).transpose(0, 1, 3, 2)
    log_i = i_pre.astype(f32).reshape(B, nc, L, H).transpose(0, 1, 3, 2)
    b = jnp.cumsum(log_f, axis=-1)
    g = b[..., -1]

    w_end = g[..., None] - b + log_i
    m_loc = jnp.max(w_end, axis=-1)
    e = jnp.exp(w_end - m_loc[..., None])
    dC = jnp.einsum('bnhlv,bnhlk->bnhvk', v * e[..., None], k)
    dn = jnp.einsum('bnhl,bnhlk->bnhk', e, k)

    def step(carry, inp):
        C, n, m = carry
        dC_c, dn_c, g_c, m_loc_c = inp
        m_new = jnp.maximum(g_c + m, m_loc_c)
        a = jnp.exp(g_c + m - m_new)
        s = jnp.exp(m_loc_c - m_new)
        C_new = a[..., None, None] * C + s[..., None, None] * dC_c
        n_new = a[..., None] * n + s[..., None] * dn_c
        return (C_new, n_new, m_new), (C, n, m)

    init = (jnp.zeros((B, H, dv, dk), f32), jnp.zeros((B, H, dk), f32), jnp.zeros((B, H), f32))
    xs = (jnp.moveaxis(dC, 1, 0), jnp.moveaxis(dn, 1, 0), jnp.moveaxis(g, 1, 0), jnp.moveaxis(m_loc, 1, 0))
    _, (C_prev, n_prev, m_prev) = lax.scan(step, init, xs)
    C_prev = jnp.moveaxis(C_prev, 0, 1)
    n_prev = jnp.moveaxis(n_prev, 0, 1)
    m_prev = jnp.moveaxis(m_prev, 0, 1)

    causal = jnp.tril(jnp.ones((L, L), dtype=bool))
    log_d = jnp.where(causal, b[..., :, None] - b[..., None, :] + log_i[..., None, :], -jnp.inf)
    log_inter = b + m_prev[..., None]
    m_t = jnp.maximum(log_inter, jnp.max(log_d, axis=-1))
    w = jnp.exp(log_d - m_t[..., None]) * jnp.einsum('bnhlk,bnhsk->bnhls', q, k)
    a_inter = jnp.exp(log_inter - m_t)
    num = jnp.einsum('bnhls,bnhsv->bnhlv', w, v) + a_inter[..., None] * jnp.einsum('bnhvk,bnhlk->bnhlv', C_prev, q)
    den = jnp.sum(w, axis=-1) + a_inter * jnp.einsum('bnhk,bnhlk->bnhl', n_prev, q)
    h = num / jnp.maximum(jnp.abs(den), jnp.exp(-m_t))[..., None]
    return h.transpose(0, 1, 3, 2, 4).reshape(B, S, H, dv)


def hybrid_layer(x, cos, sin, norm_mix, w_in, att_q_norm, att_k_norm, att_sinks, m_gate_bias,
                 m_head_norm, w_att_branch, w_m_branch, w_out, norm_ffn, w_ff1, w_ff2):
    B, S, _ = x.shape
    h = rmsnorm(x, norm_mix)
    z = h @ w_in
    splits = [int(s) for s in np.cumsum(IN_WIDTHS)[:-1]]
    q_a, k_a, v_a, q_m, k_m, v_m, o_m, if_m, gates = jnp.split(z, splits, axis=-1)

    q_a = partial_rope(rmsnorm(q_a.reshape(B, S, ATT_HEADS, ATT_HEAD_DIM), att_q_norm), cos, sin)
    k_a = partial_rope(rmsnorm(k_a.reshape(B, S, ATT_KV_HEADS, ATT_HEAD_DIM), att_k_norm), cos, sin)
    v_a = v_a.reshape(B, S, ATT_KV_HEADS, ATT_HEAD_DIM)
    att = sliding_window_attention(q_a, k_a, v_a, att_sinks)

    i_pre, f_pre = jnp.split(if_m + m_gate_bias, 2, axis=-1)
    hm = mlstm_chunkwise(q_m.reshape(B, S, M_HEADS, M_QK_DIM),
                         k_m.reshape(B, S, M_HEADS, M_QK_DIM),
                         v_m.reshape(B, S, M_HEADS, M_V_DIM), i_pre, f_pre).astype(x.dtype)
    hm = rmsnorm(hm, m_head_norm.reshape(M_HEADS, M_V_DIM)).reshape(B, S, M_V_W)
    hm = hm * jax.nn.sigmoid(o_m)

    g_a, g_m = jnp.split(gates, 2, axis=-1)
    mixed = jax.nn.sigmoid(g_a) * (att @ w_att_branch) + jax.nn.sigmoid(g_m) * (hm @ w_m_branch)
    x = x + mixed @ w_out

    u = jax.nn.relu(rmsnorm(x, norm_ffn) @ w_ff1)
    return x + (u * u) @ w_ff2


def setup_inputs(seed: int = 0) -> dict:
    key = jax.random.key(seed)
    ks = jax.random.split(key, 16)
    nrm = jax.random.normal
    f32 = jnp.float32
    x = nrm(ks[0], (BATCH, SEQ, D_MODEL), f32)
    norm_mix = 1.0 + 0.02 * nrm(ks[1], (DEPTH, D_MODEL), f32)
    w_in = nrm(ks[2], (DEPTH, D_MODEL, D_IN), f32) * D_MODEL ** -0.5
    att_q_norm = 1.0 + 0.02 * nrm(ks[3], (DEPTH, ATT_HEAD_DIM), f32)
    att_k_norm = 1.0 + 0.02 * nrm(ks[4], (DEPTH, ATT_HEAD_DIM), f32)
    att_sinks = 0.5 * nrm(ks[5], (DEPTH, ATT_HEADS), f32)
    i_bias = -1.0 + 0.1 * nrm(ks[6], (DEPTH, M_HEADS), f32)
    f_bias = 3.0 + 0.5 * nrm(ks[7], (DEPTH, M_HEADS), f32)
    m_gate_bias = jnp.concatenate([i_bias, f_bias], axis=-1)
    m_head_norm = 1.0 + 0.02 * nrm(ks[8], (DEPTH, M_V_W), f32)
    w_att_branch = nrm(ks[9], (DEPTH, ATT_Q_W, D_MODEL), f32) * ATT_Q_W ** -0.5
    w_m_branch = nrm(ks[10], (DEPTH, M_V_W, D_MODEL), f32) * M_V_W ** -0.5
    w_out = nrm(ks[11], (DEPTH, D_MODEL, D_MODEL), f32) * D_MODEL ** -0.5
    norm_ffn = 1.0 + 0.02 * nrm(ks[12], (DEPTH, D_MODEL), f32)
    w_ff1 = nrm(ks[13], (DEPTH, D_MODEL, D_FF), f32) * D_MODEL ** -0.5
    w_ff2 = nrm(ks[14], (DEPTH, D_FF, D_MODEL), f32) * D_FF ** -0.5
    return {"x": x, "norm_mix": norm_mix, "w_in": w_in, "att_q_norm": att_q_norm,
            "att_k_norm": att_k_norm, "att_sinks": att_sinks, "m_gate_bias": m_gate_bias,
            "m_head_norm": m_head_norm, "w_att_branch": w_att_branch, "w_m_branch": w_m_branch,
            "w_out": w_out, "norm_ffn": norm_ffn, "w_ff1": w_ff1, "w_ff2": w_ff2}


def reference(x, norm_mix, w_in, att_q_norm, att_k_norm, att_sinks, m_gate_bias, m_head_norm,
              w_att_branch, w_m_branch, w_out, norm_ffn, w_ff1, w_ff2):
    cos, sin = rope_tables(x.shape[1])
    for layer in range(DEPTH):
        x = hybrid_layer(x, cos, sin, norm_mix[layer], w_in[layer], att_q_norm[layer],
                         att_k_norm[layer], att_sinks[layer], m_gate_bias[layer],
                         m_head_norm[layer], w_att_branch[layer], w_m_branch[layer],
                         w_out[layer], norm_ffn[layer], w_ff1[layer], w_ff2[layer])
    return x
```

```cpp
#include <hip/hip_runtime.h>
#include <hip/hip_cooperative_groups.h>
#include <cstdio>
#include <cstdint>
#include <cmath>
namespace cg = cooperative_groups;

#ifndef MK_PER_PHASE_LAUNCH
#define MK_PER_PHASE_LAUNCH 0
#endif

#define LAS __attribute__((address_space(3)))
typedef unsigned short bf16_t;
typedef short bf16x8 __attribute__((ext_vector_type(8)));
typedef float f32x4 __attribute__((ext_vector_type(4)));
typedef float f32x2 __attribute__((ext_vector_type(2)));
typedef unsigned u32x4 __attribute__((ext_vector_type(4)));
typedef unsigned u32x2 __attribute__((ext_vector_type(2)));

constexpr int DM = 1024, BATCH = 8, SEQ = 4096, MROWS = BATCH * SEQ, DFF = 4096, DEPTH = 2;
constexpr int ZP = 4608;
constexpr int ZC_QA = 0, ZC_KA = 512, ZC_VA = 640, ZC_QM = 768, ZC_KM = 1024, ZC_VM = 1280, ZC_OM = 1792, ZC_GA = 2304, ZC_GM = 3328, ZC_IF = 4352;
constexpr int DIN_SRC = 4360;
constexpr float EPS = 1e-6f;
constexpr int NCH = 64;
constexpr int NITEM_M = BATCH * NCH * 4;

constexpr size_t MiB = 1u << 20;
constexpr size_t WS_RS = 0;
constexpr size_t WS_ROPE = 2 * MiB;
constexpr size_t WS_DN = 3 * MiB;
constexpr size_t WS_G = 4 * MiB;
constexpr size_t WS_ML = 4 * MiB + 65536;
constexpr size_t WS_MP = 4 * MiB + 131072;
constexpr size_t WS_W = 8 * MiB;
constexpr size_t WL_IN = 0, WL_AB = 9 * MiB, WL_MB = 10 * MiB, WL_OUT = 11 * MiB, WL_1 = 13 * MiB, WL_2 = 21 * MiB, WL_SIZE = 29 * MiB;
constexpr size_t WS_XB = 66 * MiB;
constexpr size_t WS_Z = 130 * MiB;
constexpr size_t WS_DC = 418 * MiB;
constexpr size_t WS_END = 482 * MiB;

constexpr int LDS_BYTES = 131072 + 64 + 9 * 256 * 4;
constexpr size_t WS_BAR = 5 * MiB;

#define GAS __attribute__((address_space(1)))
template <class T> __device__ __forceinline__ T* gptr(T* p) { return (T*)(GAS T*)p; }
__device__ __forceinline__ unsigned pk_bf16(float lo, float hi) {
    typedef __bf16 b2 __attribute__((ext_vector_type(2)));
    f32x2 v = {lo, hi}; b2 r = __builtin_convertvector(v, b2); return __builtin_bit_cast(unsigned, r);
}
__device__ __forceinline__ float bf_lo(unsigned u) { return __uint_as_float(u << 16); }
__device__ __forceinline__ float bf_hi(unsigned u) { return __uint_as_float(u & 0xffff0000u); }
__device__ __forceinline__ float bf2f(bf16_t v) { return __uint_as_float(((unsigned)v) << 16); }
__device__ __forceinline__ float sigmoidf_(float x) { return __builtin_amdgcn_rcpf(1.0f + __expf(-x)); }
__device__ __forceinline__ float xsum16(float v) { const auto r = __builtin_amdgcn_permlane16_swap(__float_as_uint(v), __float_as_uint(v), false, false); return __uint_as_float(r[0]) + __uint_as_float(r[1]); }
__device__ __forceinline__ float xsum32(float v) { const auto r = __builtin_amdgcn_permlane32_swap(__float_as_uint(v), __float_as_uint(v), false, false); return __uint_as_float(r[0]) + __uint_as_float(r[1]); }
__device__ __forceinline__ float xmax16(float v) { const auto r = __builtin_amdgcn_permlane16_swap(__float_as_uint(v), __float_as_uint(v), false, false); return fmaxf(__uint_as_float(r[0]), __uint_as_float(r[1])); }
__device__ __forceinline__ float xmax32(float v) { const auto r = __builtin_amdgcn_permlane32_swap(__float_as_uint(v), __float_as_uint(v), false, false); return fmaxf(__uint_as_float(r[0]), __uint_as_float(r[1])); }
__device__ __forceinline__ float rowsum4(float v) { return xsum32(xsum16(v)); }
__device__ __forceinline__ float rowmax4(float v) { return xmax32(xmax16(v)); }
__device__ __forceinline__ float wave_sum(float v) {
#pragma unroll
    for (int o = 1; o < 64; o <<= 1) v += __shfl_xor(v, o);
    return v;
}
__device__ __forceinline__ float wave_max(float v) {
#pragma unroll
    for (int o = 1; o < 64; o <<= 1) v = fmaxf(v, __shfl_xor(v, o));
    return v;
}

#ifndef PG8_ALIGN
#define PG8_ALIGN 1
#endif
namespace pg8 {
constexpr int BM = 256, BK = 64, HALF = 128, HTB = HALF * BK * 2, NXCD = 8, WGM = 4;
__device__ __forceinline__ int lds_byte(int r, int c) { const int st = (r >> 4) * 2 + (c >> 5), rr = r & 15, cc = c & 31, ob = rr * 64 + cc * 2; return st * 1024 + (ob ^ (((ob >> 9) & 1) << 5)); }
__device__ __forceinline__ void stage_rc(int b, int& R, int& C) { const int st = b / 1024, sb = b % 1024, swz = sb ^ (((sb >> 9) & 1) << 5); R = (st >> 1) * 16 + swz / 64; C = (st & 1) * 32 + (swz % 64) / 2; }
__device__ __forceinline__ int perm32(int rho) { const int n = rho >> 4, i = rho & 15; return 8 * (i >> 2) + 4 * n + (i & 3); }

struct Unit { int pm, pn, idx; };
struct Gemm { const bf16_t* A; const bf16_t* Bt; int M, N, K, lda; };

struct StaticOrder {
    int nM, nN, nwg, G, c;
    __device__ void init(int M, int N, int G_, int c_) { nM = M / BM; nN = N / BM; nwg = nM * nN; G = G_; c = c_; }
    __device__ bool next(int i, Unit& u) const {
        const long L = (long)i * G + c; if (L >= nwg) return false;
        int wgid = (int)L; { const int q = nwg / NXCD, r = nwg % NXCD, xcd = wgid % NXCD, off = wgid / NXCD; wgid = (xcd < r ? xcd * (q + 1) : r * (q + 1) + (xcd - r) * q) + off; }
        const int nig = WGM * nN, gid = wgid / nig, fm = gid * WGM, gsz = (nM - fm) < WGM ? (nM - fm) : WGM;
        u.pm = fm + ((wgid % nig) % gsz); u.pn = (wgid % nig) / gsz; u.idx = i; return true;
    }
};

template <class Epi>
__device__ __forceinline__ void gemm_phase(LAS unsigned char* lds, const Gemm g, const StaticOrder& S, const Epi& E) {
    int tid_ = threadIdx.x; asm volatile("" : "+v"(tid_));
    const int tid = tid_, wid = __builtin_amdgcn_readfirstlane(tid >> 6), lane = tid & 63, wr = wid >> 2, wc = wid & 3, fr = lane & 15, fq = lane >> 4;
    const int K = g.K, nt = K / BK, lda = g.lda;
    unsigned voffA[2], voffB[2];
#pragma unroll
    for (int i = 0; i < 2; ++i) { int R, C; stage_rc(tid * 16 + i * 8192, R, C); const int Rb = Epi::PERM ? ((R & ~31) + perm32(R & 31)) : R;
        voffA[i] = (unsigned)(R * lda + C) * 2u; voffB[i] = (unsigned)(Rb * K + C) * 2u; }
    const size_t kstep = (size_t)(BK * 2);
    const size_t hstepA = (size_t)HALF * lda * 2, hstepB = (size_t)HALF * K * 2;
    const size_t tstepA = 2 * hstepA, tstepB = 2 * hstepB;
    const unsigned ldsw = (unsigned)wid * 1024u;
    const int aoff = lds_byte(wr * 64 + fr, fq * 8), boff = lds_byte(wc * 32 + fr, fq * 8);
#define PG8_SA(b, h) (((b) * 2 + (h)) * HTB)
#define PG8_SB(b, h) ((4 + (b) * 2 + (h)) * HTB)
#define PG8_STAGE(bufoff, gbase, voff) do { _Pragma("unroll") for (int _i = 0; _i < 2; ++_i) \
        __builtin_amdgcn_global_load_lds((const unsigned*)((const char*)(gbase) + (voff)[_i]), (LAS unsigned*)(lds + (bufoff) + ldsw + _i * 8192), 16, 0, 0); } while (0)
#define PG8_LDA(dst, b, h) do { _Pragma("unroll") for (int m = 0; m < 4; ++m) _Pragma("unroll") for (int k = 0; k < 2; ++k) dst[m][k] = *(const LAS bf16x8*)(lds + PG8_SA(b, h) + aoff + m * 2048 + k * 1024); } while (0)
#define PG8_LDB(dst, b, h) do { _Pragma("unroll") for (int n = 0; n < 2; ++n) _Pragma("unroll") for (int k = 0; k < 2; ++k) dst[n][k] = *(const LAS bf16x8*)(lds + PG8_SB(b, h) + boff + n * 2048 + k * 1024); } while (0)
#define PG8_MMA(ai, bj, At, Bt) do { __builtin_amdgcn_s_setprio(1); _Pragma("unroll") for (int k = 0; k < 2; ++k) _Pragma("unroll") for (int m = 0; m < 4; ++m) _Pragma("unroll") for (int n = 0; n < 2; ++n) \
        acc[ai][bj][m][n] = __builtin_amdgcn_mfma_f32_16x16x32_bf16(Bt[n][k], At[m][k], acc[ai][bj][m][n], 0, 0, 0); __builtin_amdgcn_s_setprio(0); } while (0)
#define PG8_WAIT_V(n) asm volatile("s_waitcnt vmcnt(" #n ")" ::: "memory")
#define PG8_WAIT_L(n) asm volatile("s_waitcnt lgkmcnt(" #n ")" ::: "memory")
#define PG8_BAR __builtin_amdgcn_s_barrier()
#define PG8_SCHED __builtin_amdgcn_sched_barrier(0)
    Unit cur, nxt; int ui = 0;
    if (!S.next(0, cur)) return;
    f32x4 acc[2][2][4][2];
#pragma unroll
    for (int a = 0; a < 2; ++a)
#pragma unroll
        for (int b = 0; b < 2; ++b)
#pragma unroll
            for (int m = 0; m < 4; ++m)
#pragma unroll
                for (int n = 0; n < 2; ++n) acc[a][b][m][n] = (f32x4){0.f, 0.f, 0.f, 0.f};
    bf16x8 At[4][2], B0[2][2], B1[2][2];
    const char* cA = (const char*)g.A + (size_t)cur.pm * tstepA; const char* cB = (const char*)g.Bt + (size_t)cur.pn * tstepB;
    PG8_STAGE(PG8_SB(0, 0), cB, voffB); PG8_STAGE(PG8_SB(0, 1), cB + hstepB, voffB); PG8_STAGE(PG8_SA(0, 0), cA, voffA); PG8_STAGE(PG8_SA(0, 1), cA + hstepA, voffA);
    if (wr == 1) PG8_BAR;
    PG8_WAIT_V(2); PG8_BAR;
    PG8_STAGE(PG8_SB(1, 0), cB + kstep, voffB); PG8_STAGE(PG8_SA(1, 0), cA + kstep, voffA); PG8_STAGE(PG8_SB(1, 1), cB + hstepB + kstep, voffB);
    PG8_WAIT_V(6); PG8_BAR;
    for (;;) {
        const bool has_next = S.next(ui + 1, nxt);
        const char* nA = has_next ? (const char*)g.A + (size_t)nxt.pm * tstepA : cA; const char* nB = has_next ? (const char*)g.Bt + (size_t)nxt.pn * tstepB : cB;
        for (int t = 0; t < nt; t += 2) {
            const bool last = (t == nt - 2);
            const char* a1 = cA + (size_t)(t + 1) * kstep;
            const char* a2 = last ? nA : cA + (size_t)(t + 2) * kstep; const char* b2 = last ? nB : cB + (size_t)(t + 2) * kstep;
            const char* a3 = a2 + kstep; const char* b3 = b2 + kstep;
            PG8_LDB(B0, 0, 0); PG8_LDB(B1, 0, 1); PG8_SCHED; PG8_LDA(At, 0, 0); PG8_STAGE(PG8_SA(1, 1), a1 + hstepA, voffA);
            PG8_WAIT_V(8); PG8_WAIT_L(0); PG8_BAR; PG8_MMA(0, 0, At, B0); PG8_MMA(0, 1, At, B1); PG8_BAR; PG8_SCHED;
            PG8_LDA(At, 0, 1); PG8_STAGE(PG8_SB(0, 0), b2, voffB); PG8_STAGE(PG8_SB(0, 1), b2 + hstepB, voffB); PG8_STAGE(PG8_SA(0, 0), a2, voffA);
            PG8_WAIT_V(8); PG8_WAIT_L(0); PG8_BAR; PG8_MMA(1, 0, At, B0); PG8_MMA(1, 1, At, B1); PG8_BAR; PG8_SCHED;
            PG8_LDB(B0, 1, 0); PG8_LDB(B1, 1, 1); PG8_SCHED; PG8_LDA(At, 1, 0); PG8_STAGE(PG8_SA(0, 1), a2 + hstepA, voffA);
            PG8_WAIT_V(8); PG8_WAIT_L(0); PG8_BAR; PG8_MMA(0, 0, At, B0); PG8_MMA(0, 1, At, B1); PG8_BAR; PG8_SCHED;
            PG8_LDA(At, 1, 1); PG8_STAGE(PG8_SB(1, 0), b3, voffB); PG8_STAGE(PG8_SB(1, 1), b3 + hstepB, voffB); PG8_STAGE(PG8_SA(1, 0), a3, voffA);
            PG8_WAIT_V(8); PG8_WAIT_L(0); PG8_BAR; PG8_MMA(1, 0, At, B0); PG8_MMA(1, 1, At, B1); PG8_BAR; PG8_SCHED;
        }
        if (PG8_ALIGN) { if (wr == 0) PG8_BAR; }
        E(acc, cur, wr, wc, fr, fq);
        if (!has_next) break;
#pragma unroll
        for (int a = 0; a < 2; ++a)
#pragma unroll
            for (int b = 0; b < 2; ++b)
#pragma unroll
                for (int m = 0; m < 4; ++m)
#pragma unroll
                    for (int n = 0; n < 2; ++n) acc[a][b][m][n] = (f32x4){0.f, 0.f, 0.f, 0.f};
        cur = nxt; cA = nA; cB = nB; ++ui;
        if (PG8_ALIGN) { if (wr == 1) PG8_BAR; }
    }
    PG8_WAIT_V(0);
    if (!PG8_ALIGN) { if (wr == 0) PG8_BAR; }
    PG8_BAR;
#undef PG8_SA
#undef PG8_SB
#undef PG8_STAGE
#undef PG8_LDA
#undef PG8_LDB
#undef PG8_MMA
#undef PG8_WAIT_V
#undef PG8_WAIT_L
#undef PG8_BAR
#undef PG8_SCHED
}

constexpr int LINV_OFF = 131072 + 64, LINV_UNITS = 9;
template <int ACT> struct EpiScale {
    static constexpr bool PERM = true;
    bf16_t* O; int ldc; const LAS float* linv; int pad_tile;
    __device__ __forceinline__ void operator()(const f32x4 (&acc)[2][2][4][2], const Unit& u, int wr, int wc, int fr, int fq) const {
        const int row0 = u.pm * BM + wr * 64 + fr, col0 = u.pn * BM + wc * 32 + 8 * fq;
        const LAS float* li = linv + u.idx * 256 + wr * 64 + fr;
#pragma unroll
        for (int ai = 0; ai < 2; ++ai)
#pragma unroll
            for (int m = 0; m < 4; ++m) {
                const int row = row0 + ai * HALF + m * 16;
                const float inv = li[ai * HALF + m * 16];
                bf16_t* rowp = O + (size_t)row * ldc + col0;
#pragma unroll
                for (int bj = 0; bj < 2; ++bj) {
                    f32x4 v0 = acc[ai][bj][m][0] * inv, v1 = acc[ai][bj][m][1] * inv;
                    if (ACT == 1) {
#pragma unroll
                        for (int e = 0; e < 4; ++e) { const float a = fmaxf(v0[e], 0.f), b = fmaxf(v1[e], 0.f); v0[e] = a * a; v1[e] = b * b; }
                    }
                    u32x4 w; w.x = pk_bf16(v0[0], v0[1]); w.y = pk_bf16(v0[2], v0[3]); w.z = pk_bf16(v1[0], v1[1]); w.w = pk_bf16(v1[2], v1[3]);
                    if (u.pn != pad_tile || (bj == 0 && wc == 0 && fq == 0)) *(u32x4*)(rowp + bj * HALF) = w;
                }
            }
    }
};
__device__ __forceinline__ void inv_prepass(LAS float* linv, const float* rs, const StaticOrder& S) {
    int tid_ = threadIdx.x; asm volatile("" : "+v"(tid_));
    const int r = tid_ & 255, par = tid_ >> 8;
    f32x4 p[5][4]; Unit u;
#pragma unroll
    for (int k = 0; k < 5; ++k) {
        const int i = 2 * k + par;
        const bool ok = (i < LINV_UNITS) && S.next(i, u);
#pragma unroll
        for (int q = 0; q < 4; ++q) p[k][q] = ok ? *(const f32x4*)(rs + (size_t)(u.pm * BM + r) * 16 + 4 * q) : (f32x4){0.f, 0.f, 0.f, 0.f};
    }
#pragma unroll
    for (int k = 0; k < 5; ++k) {
        const int i = 2 * k + par;
        if (i < LINV_UNITS) {
            const f32x4 t = (p[k][0] + p[k][1]) + (p[k][2] + p[k][3]);
            linv[i * 256 + r] = rsqrtf(((t[0] + t[1]) + (t[2] + t[3])) * (1.0f / 1024.0f) + EPS);
        }
    }
    __syncthreads();
}
template <int ADD> struct EpiGate {
    static constexpr bool PERM = true;
    bf16_t* O; const bf16_t* Z; int gcol;
    __device__ __forceinline__ void operator()(const f32x4 (&acc)[2][2][4][2], const Unit& u, int wr, int wc, int fr, int fq) const {
        const int row0 = u.pm * BM + wr * 64 + fr, col0 = u.pn * BM + wc * 32 + 8 * fq;
        u32x4 gq[4][2], tq[4][2];
#define EG_LOAD(ai, m) do { _Pragma("unroll") for (int bj = 0; bj < 2; ++bj) { const int row = row0 + (ai) * HALF + (m) * 16, col = col0 + bj * HALF; \
            gq[m][bj] = *(const u32x4*)(Z + (size_t)row * ZP + gcol + col); \
            if (ADD) tq[m][bj] = *(const u32x4*)(O + (size_t)row * DM + col); else tq[m][bj] = (u32x4){0u, 0u, 0u, 0u}; } } while (0)
#pragma unroll
        for (int m = 0; m < 4; ++m) EG_LOAD(0, m);
        asm volatile("" ::: "memory");
#pragma unroll
        for (int ai = 0; ai < 2; ++ai)
#pragma unroll
            for (int m = 0; m < 4; ++m) {
#pragma unroll
                for (int bj = 0; bj < 2; ++bj) {
                    const int row = row0 + ai * HALF + m * 16, col = col0 + bj * HALF;
                    const u32x4 g = gq[m][bj], t = tq[m][bj];
                    const f32x4 a0 = acc[ai][bj][m][0], a1 = acc[ai][bj][m][1];
                    u32x4 w;
                    w.x = pk_bf16(bf_lo(t.x) + sigmoidf_(bf_lo(g.x)) * a0[0], bf_hi(t.x) + sigmoidf_(bf_hi(g.x)) * a0[1]);
                    w.y = pk_bf16(bf_lo(t.y) + sigmoidf_(bf_lo(g.y)) * a0[2], bf_hi(t.y) + sigmoidf_(bf_hi(g.y)) * a0[3]);
                    w.z = pk_bf16(bf_lo(t.z) + sigmoidf_(bf_lo(g.z)) * a1[0], bf_hi(t.z) + sigmoidf_(bf_hi(g.z)) * a1[1]);
                    w.w = pk_bf16(bf_lo(t.w) + sigmoidf_(bf_lo(g.w)) * a1[2], bf_hi(t.w) + sigmoidf_(bf_hi(g.w)) * a1[3]);
                    *(u32x4*)(O + (size_t)row * DM + col) = w;
                }
                asm volatile("" ::: "memory");
                if (ai == 0) { EG_LOAD(1, m); asm volatile("" ::: "memory"); }
            }
#undef EG_LOAD
    }
};
template <int FINAL> struct EpiRes {
    static constexpr bool PERM = true;
    float* out; bf16_t* xb; float* rs;
    __device__ __forceinline__ void operator()(const f32x4 (&acc)[2][2][4][2], const Unit& u, int wr, int wc, int fr, int fq) const {
        const int row0 = u.pm * BM + wr * 64 + fr, col0 = u.pn * BM + wc * 32 + 8 * fq;
        u32x4 pre[4][2];
#define ER_LOAD(ai, m) do { _Pragma("unroll") for (int bj = 0; bj < 2; ++bj) pre[m][bj] = *(const u32x4*)(xb + (size_t)(row0 + (ai) * HALF + (m) * 16) * DM + col0 + bj * HALF); } while (0)
#pragma unroll
        for (int m = 0; m < 4; ++m) ER_LOAD(0, m);
        asm volatile("" ::: "memory");
#pragma unroll
        for (int ai = 0; ai < 2; ++ai)
#pragma unroll
            for (int m = 0; m < 4; ++m) {
                const int row = row0 + ai * HALF + m * 16; float ss = 0.f;
#pragma unroll
                for (int bj = 0; bj < 2; ++bj) {
                    const size_t off = (size_t)row * DM + col0 + bj * HALF;
                    const u32x4 b = pre[m][bj];
                    const f32x4 v0 = (f32x4){bf_lo(b.x), bf_hi(b.x), bf_lo(b.y), bf_hi(b.y)} + acc[ai][bj][m][0];
                    const f32x4 v1 = (f32x4){bf_lo(b.z), bf_hi(b.z), bf_lo(b.w), bf_hi(b.w)} + acc[ai][bj][m][1];
                    if (FINAL) { *(f32x4*)(out + off) = v0; *(f32x4*)(out + off + 4) = v1; }
                    else {
                        u32x4 w; w.x = pk_bf16(v0[0], v0[1]); w.y = pk_bf16(v0[2], v0[3]); w.z = pk_bf16(v1[0], v1[1]); w.w = pk_bf16(v1[2], v1[3]);
                        *(u32x4*)(xb + off) = w;
                        ss += (v0[0] * v0[0] + v0[1] * v0[1]) + (v0[2] * v0[2] + v0[3] * v0[3]) + (v1[0] * v1[0] + v1[1] * v1[1]) + (v1[2] * v1[2] + v1[3] * v1[3]);
                    }
                }
                if (!FINAL) {
                    ss = rowsum4(ss);
                    if (fq == 0) rs[(size_t)row * 16 + u.pn * 4 + wc] = ss;
                }
                asm volatile("" ::: "memory");
                if (ai == 0) { ER_LOAD(1, m); asm volatile("" ::: "memory"); }
            }
#undef ER_LOAD
    }
};
}

struct Args {
    const float* x; const float* norm_mix; const float* w_in; const float* qn; const float* kn; const float* sinks; const float* gbias;
    const float* hn; const float* w_ab; const float* w_mb; const float* w_out; const float* norm_ffn; const float* w1; const float* w2;
    float* out; unsigned char* ws;
    float inv_freq[8];
    int ph_lo, ph_hi;
};

typedef const __attribute__((address_space(4))) Args* KArgs;
__device__ __forceinline__ int win_map(int n) { if (n < 2304) return n; if (n < 4352) return n + 8; if (n < 4360) return n - 2048; return -1; }

__device__ __forceinline__ void tr_item(const float* W, const float* gain, bf16_t* dst, int K, int Nsrc, int mode, int item, int nNb, float* s) {
    int tid_ = threadIdx.x; asm volatile("" : "+v"(tid_));
    const int tid = tid_; const int kb = item / nNb, nb = item % nNb;
    {
        const int c = tid & 255, r0 = tid >> 8; const int nd = nb * 256 + c; const int ns = mode ? win_map(nd) : nd;
        float v[32];
#pragma unroll
        for (int i = 0; i < 32; ++i) { const int k = kb * 64 + r0 + 2 * i; v[i] = (ns >= 0) ? W[(size_t)k * Nsrc + ns] : 0.f; }
        if (gain) {
#pragma unroll
            for (int i = 0; i < 32; ++i) v[i] *= gain[kb * 64 + r0 + 2 * i];
        }
#pragma unroll
        for (int i = 0; i < 32; ++i) s[c * 65 + r0 + 2 * i] = v[i];
    }
    __syncthreads();
    {
        const int kp = (tid & 31) * 2, r = tid >> 5;
#pragma unroll
        for (int i = 0; i < 16; ++i) {
            const int n = r + 16 * i;
            *(unsigned*)(dst + (size_t)(nb * 256 + n) * K + kb * 64 + kp) = pk_bf16(s[n * 65 + kp], s[n * 65 + kp + 1]);
        }
    }
    __syncthreads();
}

__device__ __forceinline__ void sincos_acc(double a, float& c, float& s) {
    const double q = rint(a * 0.63661977236758134308); const double r = a - q * 1.57079632679489661923; const int qi = ((int)q) & 3;
    const double r2 = r * r;
    const double sn = r * (1.0 + r2 * (-1.0 / 6.0 + r2 * (1.0 / 120.0 + r2 * (-1.0 / 5040.0 + r2 * (1.0 / 362880.0 + r2 * (-1.0 / 39916800.0))))));
    const double cs = 1.0 + r2 * (-0.5 + r2 * (1.0 / 24.0 + r2 * (-1.0 / 720.0 + r2 * (1.0 / 40320.0 + r2 * (-1.0 / 3628800.0 + r2 * (1.0 / 479001600.0))))));
    if (qi == 0) { c = (float)cs; s = (float)sn; } else if (qi == 1) { c = (float)(-sn); s = (float)cs; } else if (qi == 2) { c = (float)(-cs); s = (float)(-sn); } else { c = (float)sn; s = (float)(-cs); }
}

__device__ __forceinline__ void prologue(KArgs P, unsigned char* lds) {
    int tid_ = threadIdx.x; asm volatile("" : "+v"(tid_));
    const int tid = tid_, lane = tid & 63, wave = tid >> 6, G = gridDim.x;
    float* s = (float*)lds;
    constexpr int I_IN = 16 * 18, I_AB = 8 * 4, I_MB = 8 * 4, I_OUT = 16 * 4, I_1 = 16 * 16, I_2 = 64 * 4, I_L = I_IN + I_AB + I_MB + I_OUT + I_1 + I_2;
    for (int it = blockIdx.x; it < DEPTH * I_L; it += G) {
        const int l = it / I_L; int r = it % I_L;
        unsigned char* wl = gptr(P->ws) + WS_W + (size_t)l * WL_SIZE;
        if (r < I_IN) { tr_item(gptr(P->w_in) + (size_t)l * DM * DIN_SRC, gptr(P->norm_mix) + l * DM, (bf16_t*)(wl + WL_IN), DM, DIN_SRC, 1, r, 18, s); continue; } r -= I_IN;
        if (r < I_AB) { tr_item(gptr(P->w_ab) + (size_t)l * 512 * DM, nullptr, (bf16_t*)(wl + WL_AB), 512, DM, 0, r, 4, s); continue; } r -= I_AB;
        if (r < I_MB) { tr_item(gptr(P->w_mb) + (size_t)l * 512 * DM, nullptr, (bf16_t*)(wl + WL_MB), 512, DM, 0, r, 4, s); continue; } r -= I_MB;
        if (r < I_OUT) { tr_item(gptr(P->w_out) + (size_t)l * DM * DM, nullptr, (bf16_t*)(wl + WL_OUT), DM, DM, 0, r, 4, s); continue; } r -= I_OUT;
        if (r < I_1) { tr_item(gptr(P->w1) + (size_t)l * DM * DFF, gptr(P->norm_ffn) + l * DM, (bf16_t*)(wl + WL_1), DM, DFF, 0, r, 16, s); continue; } r -= I_1;
        tr_item(gptr(P->w2) + (size_t)l * DFF * DM, nullptr, (bf16_t*)(wl + WL_2), DFF, DM, 0, r, 4, s);
    }
    {
        bf16_t* xb = (bf16_t*)(gptr(P->ws) + WS_XB); float* rs = (float*)(gptr(P->ws) + WS_RS);
        const int gw = blockIdx.x * 8 + wave, NGW = G * 8;
        for (int row0 = gw * 4; row0 < MROWS; row0 += NGW * 4) {
            f32x4 v[4][4];
#pragma unroll
            for (int rr = 0; rr < 4; ++rr) { const f32x4* xr = (const f32x4*)(gptr(P->x) + (size_t)(row0 + rr) * DM) + lane;
#pragma unroll
                for (int j = 0; j < 4; ++j) v[rr][j] = xr[64 * j]; }
#pragma unroll
            for (int rr = 0; rr < 4; ++rr) {
                const int row = row0 + rr; float ss = 0.f;
#pragma unroll
                for (int j = 0; j < 4; ++j) ss += (v[rr][j][0] * v[rr][j][0] + v[rr][j][1] * v[rr][j][1]) + (v[rr][j][2] * v[rr][j][2] + v[rr][j][3] * v[rr][j][3]);
                ss = wave_sum(ss);
                u32x2* o = (u32x2*)(xb + (size_t)row * DM) + lane;
#pragma unroll
                for (int j = 0; j < 4; ++j) { u32x2 w; w.x = pk_bf16(v[rr][j][0], v[rr][j][1]); w.y = pk_bf16(v[rr][j][2], v[rr][j][3]); o[64 * j] = w; }
                if (lane < 4) { f32x4 z = {0.f, 0.f, 0.f, 0.f}; if (lane == 0) z[0] = ss; *((f32x4*)(rs + (size_t)row * 16) + lane) = z; }
            }
        }
    }
    {
        f32x2* rope = (f32x2*)(gptr(P->ws) + WS_ROPE);
        for (int e = blockIdx.x * 512 + tid; e < SEQ * 8; e += G * 512) {
            const int pos = e >> 3, i = e & 7; const float ang = (float)pos * P->inv_freq[i];
            float c, sn; sincos_acc((double)ang, c, sn); rope[e] = (f32x2){c, sn};
        }
    }
}

__device__ __forceinline__ void attn_item(unsigned char* lds, bf16_t* Z, const f32x2* rope, const float* qn, const float* kn, const float* sinks, int item) {
    int tid_ = threadIdx.x; asm volatile("" : "+v"(tid_));
    const int tid = tid_, lane = tid & 63, w = __builtin_amdgcn_readfirstlane(tid >> 6), l15 = lane & 15, g = lane >> 4;
    const int kvh = item & 1, n = (item >> 1) & 31, b = item >> 6;
    bf16_t* Ks = (bf16_t*)lds;
    bf16_t* VT = (bf16_t*)(lds + 256 * 144);
    const size_t rowbase = (size_t)b * SEQ;
    const int pos0 = 128 * (n - 1);
    const int qpos = 128 * n + 16 * w + l15;
    const size_t grow = rowbase + qpos;
    u32x4 qn0, qn1;
    { const bf16_t* q0 = Z + grow * ZP + ZC_QA + (kvh * 4) * 64 + 8 * g; qn0 = *(const u32x4*)(q0); qn1 = *(const u32x4*)(q0 + 32); }
    if (tid < 256) {
        const int key = tid, pos = pos0 + key;
        u32x4 raw[8];
        if (pos >= 0) {
            const u32x4* src = (const u32x4*)(Z + (rowbase + pos) * ZP + ZC_KA + kvh * 64);
#pragma unroll
            for (int i = 0; i < 8; ++i) raw[i] = src[i];
        } else {
#pragma unroll
            for (int i = 0; i < 8; ++i) raw[i] = (u32x4){0u, 0u, 0u, 0u};
        }
        float ss = 0.f;
#pragma unroll
        for (int i = 0; i < 8; ++i) { const u32x4 r = raw[i];
            ss += bf_lo(r.x) * bf_lo(r.x) + bf_hi(r.x) * bf_hi(r.x) + bf_lo(r.y) * bf_lo(r.y) + bf_hi(r.y) * bf_hi(r.y) + bf_lo(r.z) * bf_lo(r.z) + bf_hi(r.z) * bf_hi(r.z) + bf_lo(r.w) * bf_lo(r.w) + bf_hi(r.w) * bf_hi(r.w); }
        const float inv = rsqrtf(ss * (1.0f / 64.0f) + EPS);
        const int pp = pos >= 0 ? pos : 0;
        u32x4* dst = (u32x4*)(Ks + key * 72);
        {
            float a[8], bq[8];
            { const u32x4 r = raw[0]; a[0] = bf_lo(r.x); a[1] = bf_hi(r.x); a[2] = bf_lo(r.y); a[3] = bf_hi(r.y); a[4] = bf_lo(r.z); a[5] = bf_hi(r.z); a[6] = bf_lo(r.w); a[7] = bf_hi(r.w); }
            { const u32x4 r = raw[1]; bq[0] = bf_lo(r.x); bq[1] = bf_hi(r.x); bq[2] = bf_lo(r.y); bq[3] = bf_hi(r.y); bq[4] = bf_lo(r.z); bq[5] = bf_hi(r.z); bq[6] = bf_lo(r.w); bq[7] = bf_hi(r.w); }
#pragma unroll
            for (int i = 0; i < 8; ++i) { const f32x2 cs = rope[pp * 8 + i]; const float x1 = a[i] * inv * kn[i], x2 = bq[i] * inv * kn[8 + i]; a[i] = x1 * cs[0] - x2 * cs[1]; bq[i] = x2 * cs[0] + x1 * cs[1]; }
            u32x4 r; r.x = pk_bf16(a[0], a[1]); r.y = pk_bf16(a[2], a[3]); r.z = pk_bf16(a[4], a[5]); r.w = pk_bf16(a[6], a[7]); dst[0] = r;
            r.x = pk_bf16(bq[0], bq[1]); r.y = pk_bf16(bq[2], bq[3]); r.z = pk_bf16(bq[4], bq[5]); r.w = pk_bf16(bq[6], bq[7]); dst[1] = r;
        }
#pragma unroll
        for (int i = 2; i < 8; ++i) { const u32x4 r = raw[i]; const float* kg = kn + 8 * i; u32x4 o;
            o.x = pk_bf16(bf_lo(r.x) * inv * kg[0], bf_hi(r.x) * inv * kg[1]); o.y = pk_bf16(bf_lo(r.y) * inv * kg[2], bf_hi(r.y) * inv * kg[3]);
            o.z = pk_bf16(bf_lo(r.z) * inv * kg[4], bf_hi(r.z) * inv * kg[5]); o.w = pk_bf16(bf_lo(r.w) * inv * kg[6], bf_hi(r.w) * inv * kg[7]); dst[i] = o; }
    } else {
        const int key = tid - 256, pos = pos0 + key;
        const u32x4* src = (const u32x4*)(Z + (rowbase + (pos >= 0 ? pos : 0)) * ZP + ZC_VA + kvh * 64);
#pragma unroll
        for (int i = 0; i < 8; ++i) {
            u32x4 r = src[i]; if (pos < 0) r = (u32x4){0u, 0u, 0u, 0u};
            VT[(8 * i + 0) * 264 + key] = (bf16_t)(r.x & 0xffffu); VT[(8 * i + 1) * 264 + key] = (bf16_t)(r.x >> 16);
            VT[(8 * i + 2) * 264 + key] = (bf16_t)(r.y & 0xffffu); VT[(8 * i + 3) * 264 + key] = (bf16_t)(r.y >> 16);
            VT[(8 * i + 4) * 264 + key] = (bf16_t)(r.z & 0xffffu); VT[(8 * i + 5) * 264 + key] = (bf16_t)(r.z >> 16);
            VT[(8 * i + 6) * 264 + key] = (bf16_t)(r.w & 0xffffu); VT[(8 * i + 7) * 264 + key] = (bf16_t)(r.w >> 16);
        }
    }
    __syncthreads();
#pragma unroll 2
    for (int hh = 0; hh < 4; ++hh) {
        const int head = kvh * 4 + hh;
        bf16_t* qptr = Z + grow * ZP + ZC_QA + head * 64;
        float xq[2][8];
        const u32x4 qr0 = qn0, qr1 = qn1;
        if (hh < 3) { qn0 = *(const u32x4*)(qptr + 64 + 8 * g); qn1 = *(const u32x4*)(qptr + 64 + 32 + 8 * g); }
#pragma unroll
        for (int kk = 0; kk < 2; ++kk) { const u32x4 r = kk == 0 ? qr0 : qr1;
            xq[kk][0] = bf_lo(r.x); xq[kk][1] = bf_hi(r.x); xq[kk][2] = bf_lo(r.y); xq[kk][3] = bf_hi(r.y); xq[kk][4] = bf_lo(r.z); xq[kk][5] = bf_hi(r.z); xq[kk][6] = bf_lo(r.w); xq[kk][7] = bf_hi(r.w); }
        float ss = 0.f;
#pragma unroll
        for (int kk = 0; kk < 2; ++kk)
#pragma unroll
            for (int i = 0; i < 8; ++i) ss += xq[kk][i] * xq[kk][i];
        ss = rowsum4(ss);
        const float inv = rsqrtf(ss * (1.0f / 64.0f) + EPS);
#pragma unroll
        for (int kk = 0; kk < 2; ++kk)
#pragma unroll
            for (int i = 0; i < 8; ++i) xq[kk][i] = xq[kk][i] * inv * qn[32 * kk + 8 * g + i];
#pragma unroll
        for (int i = 0; i < 8; ++i) {
            const auto pr = __builtin_amdgcn_permlane16_swap(__float_as_uint(xq[0][i]), __float_as_uint(xq[0][i]), false, false);
            const float other = __uint_as_float((g & 1) ? pr[0] : pr[1]); const f32x2 cs = rope[qpos * 8 + i];
            if (g == 0) xq[0][i] = xq[0][i] * cs[0] - other * cs[1];
            else if (g == 1) xq[0][i] = xq[0][i] * cs[0] + other * cs[1];
        }
        bf16x8 qf[2];
#pragma unroll
        for (int kk = 0; kk < 2; ++kk) { u32x4 r; const float qsc = 0.125f * 1.4426950408889634f; r.x = pk_bf16(xq[kk][0] * qsc, xq[kk][1] * qsc); r.y = pk_bf16(xq[kk][2] * qsc, xq[kk][3] * qsc); r.z = pk_bf16(xq[kk][4] * qsc, xq[kk][5] * qsc); r.w = pk_bf16(xq[kk][6] * qsc, xq[kk][7] * qsc); qf[kk] = __builtin_bit_cast(bf16x8, r); }
        f32x4 sc[9];
#pragma unroll
        for (int t = 0; t < 9; ++t) {
            const int kt = w + t;
            const bf16x8 a0 = *(const bf16x8*)(Ks + (16 * kt + l15) * 72 + 8 * g), a1 = *(const bf16x8*)(Ks + (16 * kt + l15) * 72 + 32 + 8 * g);
            f32x4 c = {0.f, 0.f, 0.f, 0.f};
            c = __builtin_amdgcn_mfma_f32_16x16x32_bf16(a0, qf[0], c, 0, 0, 0);
            c = __builtin_amdgcn_mfma_f32_16x16x32_bf16(a1, qf[1], c, 0, 0, 0);
            sc[t] = c;
        }
        const float sink = sinks[head] * 1.4426950408889634f;
        float mx = sink;
        const int dlt = 4 * g - l15;
#pragma unroll
        for (int t = 0; t < 9; ++t) {
            const bool tile_ok = (n > 0) || (w + t >= 8);
#pragma unroll
            for (int j = 0; j < 4; ++j) {
                bool valid = tile_ok;
                if (t == 0) valid = valid && (dlt + j > 0);
                if (t == 8) valid = (dlt + j <= 0);
                sc[t][j] = valid ? sc[t][j] : -INFINITY;
                mx = fmaxf(mx, sc[t][j]);
            }
        }
        mx = rowmax4(mx);
        float sum = 0.f;
#pragma unroll
        for (int t = 0; t < 9; ++t)
#pragma unroll
            for (int j = 0; j < 4; ++j) { const float p = __builtin_amdgcn_exp2f(sc[t][j] - mx); sc[t][j] = p; sum += p; }
        sum = rowsum4(sum);
        const float rden = __builtin_amdgcn_rcpf(sum + __builtin_amdgcn_exp2f(sink - mx));
        f32x4 o[4];
#pragma unroll
        for (int dt = 0; dt < 4; ++dt) o[dt] = (f32x4){0.f, 0.f, 0.f, 0.f};
#pragma unroll
        for (int pp = 0; pp < 5; ++pp) {
            const int t0 = 2 * pp, t1 = (2 * pp + 1 < 9) ? 2 * pp + 1 : 2 * pp;
            u32x4 pb; pb.x = pk_bf16(sc[t0][0] * rden, sc[t0][1] * rden); pb.y = pk_bf16(sc[t0][2] * rden, sc[t0][3] * rden);
            if (2 * pp + 1 < 9) { pb.z = pk_bf16(sc[t1][0] * rden, sc[t1][1] * rden); pb.w = pk_bf16(sc[t1][2] * rden, sc[t1][3] * rden); } else { pb.z = 0u; pb.w = 0u; }
            const bf16x8 bfrag = __builtin_bit_cast(bf16x8, pb);
            const int k0 = 16 * (w + t0) + 4 * g, k1 = 16 * (w + t1) + 4 * g;
#pragma unroll
            for (int dt = 0; dt < 4; ++dt) {
                const bf16_t* vr = VT + (16 * dt + l15) * 264;
                const u32x2 lo = *(const u32x2*)(vr + k0), hi = *(const u32x2*)(vr + k1);
                const u32x4 av = {lo.x, lo.y, hi.x, hi.y};
                o[dt] = __builtin_amdgcn_mfma_f32_16x16x32_bf16(__builtin_bit_cast(bf16x8, av), bfrag, o[dt], 0, 0, 0);
            }
        }
#pragma unroll
        for (int dt = 0; dt < 4; ++dt) { u32x2 r; r.x = pk_bf16(o[dt][0], o[dt][1]); r.y = pk_bf16(o[dt][2], o[dt][3]); *(u32x2*)(qptr + 16 * dt + 4 * g) = r; }
    }
    __syncthreads();
}

__device__ __forceinline__ float logsigmoidf_(float x) { return fminf(x, 0.f) - __logf(1.0f + __expf(-fabsf(x))); }

__device__ __forceinline__ void m1_item4(unsigned char* lds, const bf16_t* Z, const float* gbias, bf16_t* dC, float* dn, float* gArr, float* mlArr, int item4) {
    int tid_ = threadIdx.x; asm volatile("" : "+v"(tid_));
    const int tid = tid_, lane = tid & 63, w = __builtin_amdgcn_readfirstlane(tid >> 6), l15 = lane & 15, g = lane >> 4;
    const int c = item4 & 63, b = item4 >> 6;
    const size_t rowbase = (size_t)b * SEQ + c * 64;
    constexpr int HB = 28160;
    const int t = tid & 63, pc = tid >> 6;
    const bf16_t* zr = Z + (rowbase + t) * ZP;
    u32x4 rk[4], rv0[4], rv1[4];
#pragma unroll
    for (int j = 0; j < 4; ++j) {
        rk[j] = *(const u32x4*)(zr + ZC_KM + j * 64 + 8 * pc);
        rv0[j] = *(const u32x4*)(zr + ZC_VM + j * 128 + 8 * pc);
        rv1[j] = *(const u32x4*)(zr + ZC_VM + j * 128 + 8 * (pc + 8));
    }
    if (w < 4) {
        const int h = w;
        const u32x4 gq = *(const u32x4*)(zr + ZC_IF);
        const unsigned iw = (h < 2) ? gq.x : gq.y, fw = (h < 2) ? gq.z : gq.w;
        const float ipre = ((h & 1) ? bf_hi(iw) : bf_lo(iw)) + gbias[h], fpre = ((h & 1) ? bf_hi(fw) : bf_lo(fw)) + gbias[4 + h];
        float v = logsigmoidf_(fpre);
#pragma unroll
        for (int o = 1; o < 64; o <<= 1) { const float u = __shfl_up(v, o); if (lane >= o) v += u; }
        const float gt = __shfl(v, 63);
        const float wend = gt - v + ipre;
        const float ml = wave_max(wend);
        ((float*)(lds + h * HB))[lane] = __expf(wend - ml);
        if (lane == 0) { gArr[item4 * 4 + h] = gt; mlArr[item4 * 4 + h] = ml; }
    }
    __syncthreads();
#pragma unroll
    for (int j = 0; j < 4; ++j) {
        const float e = ((const float*)(lds + j * HB))[t];
        bf16_t* KT = (bf16_t*)(lds + j * HB + 256); bf16_t* VT = KT + 64 * 72;
        const u32x4 r = rk[j];
        const unsigned p0 = pk_bf16(bf_lo(r.x) * e, bf_hi(r.x) * e), p1 = pk_bf16(bf_lo(r.y) * e, bf_hi(r.y) * e), p2 = pk_bf16(bf_lo(r.z) * e, bf_hi(r.z) * e), p3 = pk_bf16(bf_lo(r.w) * e, bf_hi(r.w) * e);
        bf16_t* d = KT + (8 * pc) * 72 + t;
        d[0] = (bf16_t)(p0 & 0xffffu); d[72] = (bf16_t)(p0 >> 16); d[144] = (bf16_t)(p1 & 0xffffu); d[216] = (bf16_t)(p1 >> 16);
        d[288] = (bf16_t)(p2 & 0xffffu); d[360] = (bf16_t)(p2 >> 16); d[432] = (bf16_t)(p3 & 0xffffu); d[504] = (bf16_t)(p3 >> 16);
#pragma unroll
        for (int rep = 0; rep < 2; ++rep) {
            const int pv = pc + 8 * rep;
            const u32x4 q = rep == 0 ? rv0[j] : rv1[j];
            bf16_t* dv = VT + (8 * pv) * 72 + t;
            dv[0] = (bf16_t)(q.x & 0xffffu); dv[72] = (bf16_t)(q.x >> 16); dv[144] = (bf16_t)(q.y & 0xffffu); dv[216] = (bf16_t)(q.y >> 16);
            dv[288] = (bf16_t)(q.z & 0xffffu); dv[360] = (bf16_t)(q.z >> 16); dv[432] = (bf16_t)(q.w & 0xffffu); dv[504] = (bf16_t)(q.w >> 16);
        }
    }
    __syncthreads();
#pragma unroll
    for (int j = 0; j < 4; ++j) {
        const bf16_t* KT = (const bf16_t*)(lds + j * HB + 256); const bf16_t* VT = KT + 64 * 72;
        const bf16_t* ar = VT + (16 * w + l15) * 72 + 8 * g;
        const bf16x8 a0 = *(const bf16x8*)(ar), a1 = *(const bf16x8*)(ar + 32);
        bf16_t* dst = dC + (size_t)(item4 * 4 + j) * 8192 + (16 * w + l15) * 64 + 4 * g;
#pragma unroll
        for (int kt = 0; kt < 4; ++kt) {
            const bf16_t* br = KT + (16 * kt + l15) * 72 + 8 * g;
            const bf16x8 b0 = *(const bf16x8*)(br), b1 = *(const bf16x8*)(br + 32);
            f32x4 acc = {0.f, 0.f, 0.f, 0.f};
            acc = __builtin_amdgcn_mfma_f32_16x16x32_bf16(b0, a0, acc, 0, 0, 0);
            acc = __builtin_amdgcn_mfma_f32_16x16x32_bf16(b1, a1, acc, 0, 0, 0);
            u32x2 o; o.x = pk_bf16(acc[0], acc[1]); o.y = pk_bf16(acc[2], acc[3]);
            *(u32x2*)(dst + 16 * kt) = o;
        }
    }
    if (tid < 256) {
        const int j = tid >> 6, k = tid & 63;
        float s = 0.f; const bf16_t* kr = (const bf16_t*)(lds + j * HB + 256) + k * 72;
#pragma unroll 8
        for (int tt = 0; tt < 64; ++tt) s += bf2f(kr[tt]);
        dn[(size_t)(item4 * 4 + j) * 64 + k] = s;
    }
    __syncthreads();
}

__device__ __forceinline__ float rdlane(float v, int l) { return __int_as_float(__builtin_amdgcn_readlane(__float_as_int(v), l)); }
__device__ __forceinline__ void scan_item(unsigned char* lds, unsigned* dC, float* dn, const float* gArr, const float* mlArr, float* mp, int item) {
    int tid_ = threadIdx.x; asm volatile("" : "+v"(tid_));
    const int tid = tid_, lane = tid & 63;
    const int bh = item >> 3, sl = item & 7, b = bh >> 2, h = bh & 3;
    const int base_idx = (b * NCH) * 4 + h;
    float* sa_ = (float*)lds; float* ss_ = sa_ + 64;
    if (tid < 64) {
        const float gv = gArr[base_idx + 4 * lane], mlv = mlArr[base_idx + 4 * lane];
        float av = 0.f, sv = 0.f, mv = 0.f, m = 0.f;
#pragma unroll
        for (int c = 0; c < 64; ++c) {
            const float gc = rdlane(gv, c), ml = rdlane(mlv, c);
            const float mnew = fmaxf(gc + m, ml);
            const float a = __expf(gc + m - mnew), s_ = __expf(ml - mnew);
            if (lane == c) { av = a; sv = s_; mv = m; }
            m = mnew;
        }
        sa_[lane] = av; ss_[lane] = sv;
        if (sl == 0) mp[base_idx + 4 * lane] = mv;
    }
    __syncthreads();
    const bool do_n = (sl == 0) && (tid < 64);
    unsigned* p = dC + (size_t)base_idx * 4096 + sl * 512 + tid;
    float* pn = dn + (size_t)base_idx * 64 + (tid & 63);
    float C0 = 0.f, C1 = 0.f, nst = 0.f;
    unsigned cv[8]; float cnv[8];
#pragma unroll
    for (int i = 0; i < 8; ++i) { cv[i] = p[(size_t)i * 16384]; cnv[i] = do_n ? pn[i * 256] : 0.f; }
#pragma unroll
    for (int cg = 0; cg < 8; ++cg) {
        unsigned nv[8]; float nnv[8];
        if (cg < 7) {
#pragma unroll
            for (int i = 0; i < 8; ++i) { const int c = cg * 8 + 8 + i; nv[i] = p[(size_t)c * 16384]; nnv[i] = do_n ? pn[c * 256] : 0.f; }
        }
        asm volatile("" ::: "memory");
#pragma unroll
        for (int i = 0; i < 8; ++i) {
            const int c = cg * 8 + i;
            const float a = sa_[c], s_ = ss_[c];
            p[(size_t)c * 16384] = pk_bf16(C0, C1); if (do_n) pn[c * 256] = nst;
            C0 = a * C0 + s_ * bf_lo(cv[i]); C1 = a * C1 + s_ * bf_hi(cv[i]); nst = a * nst + s_ * cnv[i];
        }
        if (cg < 7) {
#pragma unroll
            for (int i = 0; i < 8; ++i) { cv[i] = nv[i]; cnv[i] = nnv[i]; }
        }
    }
    __syncthreads();
}

__device__ __forceinline__ void m3_item(unsigned char* lds, bf16_t* Z, const float* gbias, const float* hn, const bf16_t* Cp, const float* np, const float* mp, int item) {
    int tid_ = threadIdx.x; asm volatile("" : "+v"(tid_));
    const int tid = tid_, lane = tid & 63, w = __builtin_amdgcn_readfirstlane(tid >> 6), l15 = lane & 15, g = lane >> 4;
    const int hp = item & 1, c = (item >> 1) & 63, b = item >> 7;
    const int gr = w >> 2, tt = w & 3, h = 2 * hp + gr, tg = tid & 255;
    const int idx = (b * NCH + c) * 4 + h;
    const size_t rowbase = (size_t)b * SEQ + c * 64;
    unsigned char* gl = lds + gr * 20480;
    bf16_t* VT = (bf16_t*)gl;
    float* sb = (float*)(gl + 18432);
    float* su = sb + 64;
    float* sm = sb + 128;
    float* sa = sb + 192;
    const int t = 16 * tt + l15;
    bf16_t* zrow = Z + (rowbase + t) * ZP;
    u32x4 vq[4];
#pragma unroll
    for (int rep = 0; rep < 4; ++rep) vq[rep] = *(const u32x4*)(Z + (rowbase + (tg & 63)) * ZP + ZC_VM + h * 128 + 8 * ((tg >> 6) + 4 * rep));
    unsigned ifp = 0u; float mprev = 0.f;
    if (tt == 0) { const bf16_t* zr = Z + (rowbase + lane) * ZP + ZC_IF; ifp = (unsigned)zr[h] | ((unsigned)zr[4 + h] << 16); mprev = mp[idx]; }
    u32x4 qraw[2];
#pragma unroll
    for (int kk = 0; kk < 2; ++kk) qraw[kk] = *(const u32x4*)(zrow + ZC_QM + h * 64 + 8 * g + 32 * kk);
    u32x4 kraw[4][2];
#pragma unroll
    for (int st = 0; st < 4; ++st)
#pragma unroll
        for (int kk = 0; kk < 2; ++kk) {
            kraw[st][kk] = (u32x4){0u, 0u, 0u, 0u};
            if (st <= tt) kraw[st][kk] = *(const u32x4*)(Z + (rowbase + 16 * st + l15) * ZP + ZC_KM + h * 64 + 8 * g + 32 * kk);
        }
    u32x2 og[8];
#pragma unroll
    for (int vt = 0; vt < 8; ++vt) og[vt] = *(const u32x2*)(zrow + ZC_OM + h * 128 + 16 * vt + 4 * g);
    const bf16_t* cb = Cp + (size_t)idx * 8192 + l15 * 64 + 8 * g;
    u32x4 cpre[8][2];
#pragma unroll
    for (int vt = 0; vt < 8; ++vt)
#pragma unroll
        for (int kk = 0; kk < 2; ++kk) cpre[vt][kk] = *(const u32x4*)(cb + vt * 1024 + 32 * kk);
    f32x4 npre[2][2];
#pragma unroll
    for (int kk = 0; kk < 2; ++kk) { npre[kk][0] = (f32x4){0.f, 0.f, 0.f, 0.f}; npre[kk][1] = npre[kk][0];
        if (l15 == 0) { npre[kk][0] = *(const f32x4*)(np + (size_t)idx * 64 + 32 * kk + 8 * g); npre[kk][1] = *(const f32x4*)(np + (size_t)idx * 64 + 32 * kk + 8 * g + 4); } }
    if (tt == 0) {
        const float ipre = bf_lo(ifp) + gbias[h], fpre = bf_hi(ifp) + gbias[4 + h];
        float v = logsigmoidf_(fpre);
#pragma unroll
        for (int o = 1; o < 64; o <<= 1) { const float u = __shfl_up(v, o); if (lane >= o) v += u; }
        const float u = ipre - v;
        float pm = u;
#pragma unroll
        for (int o = 1; o < 64; o <<= 1) { const float q = __shfl_up(pm, o); if (lane >= o) pm = fmaxf(pm, q); }
        const float mt = v + fmaxf(mprev, pm);
        sb[lane] = v; su[lane] = u; sm[lane] = mt; sa[lane] = __expf(v + mprev - mt);
    }
    {
        const int ts = tg & 63;
#pragma unroll
        for (int rep = 0; rep < 4; ++rep) {
            const int pv = (tg >> 6) + 4 * rep;
            const u32x4 q = vq[rep];
            bf16_t* dv = VT + (8 * pv) * 72 + ts;
            dv[0] = (bf16_t)(q.x & 0xffffu); dv[72] = (bf16_t)(q.x >> 16); dv[144] = (bf16_t)(q.y & 0xffffu); dv[216] = (bf16_t)(q.y >> 16);
            dv[288] = (bf16_t)(q.z & 0xffffu); dv[360] = (bf16_t)(q.z >> 16); dv[432] = (bf16_t)(q.w & 0xffffu); dv[504] = (bf16_t)(q.w >> 16);
        }
    }
    __syncthreads();
    {
        const float bt = sb[t], mt = sm[t], at = sa[t];
        bf16x8 qf[2], qs[2];
#pragma unroll
        for (int kk = 0; kk < 2; ++kk) {
            const u32x4 r = qraw[kk]; qf[kk] = __builtin_bit_cast(bf16x8, r);
            const float sc = at * 0.125f; u32x4 s;
            s.x = pk_bf16(bf_lo(r.x) * sc, bf_hi(r.x) * sc); s.y = pk_bf16(bf_lo(r.y) * sc, bf_hi(r.y) * sc); s.z = pk_bf16(bf_lo(r.z) * sc, bf_hi(r.z) * sc); s.w = pk_bf16(bf_lo(r.w) * sc, bf_hi(r.w) * sc);
            qs[kk] = __builtin_bit_cast(bf16x8, s);
        }
        f32x4 wv[4]; float dsum = 0.f;
#pragma unroll
        for (int st = 0; st < 4; ++st) {
            wv[st] = (f32x4){0.f, 0.f, 0.f, 0.f};
            if (st <= tt) {
                f32x4 s = {0.f, 0.f, 0.f, 0.f};
                s = __builtin_amdgcn_mfma_f32_16x16x32_bf16(__builtin_bit_cast(bf16x8, kraw[st][0]), qf[0], s, 0, 0, 0);
                s = __builtin_amdgcn_mfma_f32_16x16x32_bf16(__builtin_bit_cast(bf16x8, kraw[st][1]), qf[1], s, 0, 0, 0);
#pragma unroll
                for (int j = 0; j < 4; ++j) {
                    const int sp = 16 * st + 4 * g + j;
                    const float wgt = (sp <= t) ? __expf(bt + su[sp] - mt) * s[j] * 0.125f : 0.f;
                    wv[st][j] = wgt; dsum += wgt;
                }
            }
        }
        dsum = rowsum4(dsum);
        f32x4 num[8];
#pragma unroll
        for (int vt = 0; vt < 8; ++vt) num[vt] = (f32x4){0.f, 0.f, 0.f, 0.f};
#pragma unroll
        for (int vt = 0; vt < 8; ++vt)
#pragma unroll
            for (int kk = 0; kk < 2; ++kk) num[vt] = __builtin_amdgcn_mfma_f32_16x16x32_bf16(__builtin_bit_cast(bf16x8, cpre[vt][kk]), qs[kk], num[vt], 0, 0, 0);
        f32x4 nacc = {0.f, 0.f, 0.f, 0.f};
#pragma unroll
        for (int kk = 0; kk < 2; ++kk) {
            const f32x4 c0 = npre[kk][0], c1 = npre[kk][1];
            u32x4 cv; cv.x = pk_bf16(c0[0], c0[1]); cv.y = pk_bf16(c0[2], c0[3]); cv.z = pk_bf16(c1[0], c1[1]); cv.w = pk_bf16(c1[2], c1[3]);
            nacc = __builtin_amdgcn_mfma_f32_16x16x32_bf16(__builtin_bit_cast(bf16x8, cv), qs[kk], nacc, 0, 0, 0);
        }
        const float nq = __shfl(nacc[0], l15);
#pragma unroll
        for (int k2 = 0; k2 < 2; ++k2) {
            if (2 * k2 <= tt) {
                u32x4 pb; pb.x = pk_bf16(wv[2 * k2][0], wv[2 * k2][1]); pb.y = pk_bf16(wv[2 * k2][2], wv[2 * k2][3]); pb.z = pk_bf16(wv[2 * k2 + 1][0], wv[2 * k2 + 1][1]); pb.w = pk_bf16(wv[2 * k2 + 1][2], wv[2 * k2 + 1][3]);
                const bf16x8 bfrag = __builtin_bit_cast(bf16x8, pb);
#pragma unroll
                for (int vt = 0; vt < 8; ++vt) {
                    const bf16_t* vr = VT + (16 * vt + l15) * 72 + 32 * k2 + 4 * g;
                    const u32x2 lo = *(const u32x2*)(vr), hi = *(const u32x2*)(vr + 16);
                    const u32x4 av = {lo.x, lo.y, hi.x, hi.y};
                    num[vt] = __builtin_amdgcn_mfma_f32_16x16x32_bf16(__builtin_bit_cast(bf16x8, av), bfrag, num[vt], 0, 0, 0);
                }
            }
        }
        const float den = dsum + nq;
        const float rd = __builtin_amdgcn_rcpf(fmaxf(fabsf(den), __expf(-mt)));
        float ss = 0.f;
#pragma unroll
        for (int vt = 0; vt < 8; ++vt) { num[vt] = num[vt] * rd; ss += (num[vt][0] * num[vt][0] + num[vt][1] * num[vt][1]) + (num[vt][2] * num[vt][2] + num[vt][3] * num[vt][3]); }
        ss = rowsum4(ss);
        const float rinv = rsqrtf(ss * (1.0f / 128.0f) + EPS);
#pragma unroll
        for (int vt = 0; vt < 8; ++vt) {
            const int v0 = h * 128 + 16 * vt + 4 * g;
            const f32x4 gn = *(const f32x4*)(hn + v0);
            const u32x2 o2 = og[vt];
            u32x2 r;
            r.x = pk_bf16(num[vt][0] * rinv * gn[0] * sigmoidf_(bf_lo(o2.x)), num[vt][1] * rinv * gn[1] * sigmoidf_(bf_hi(o2.x)));
            r.y = pk_bf16(num[vt][2] * rinv * gn[2] * sigmoidf_(bf_lo(o2.y)), num[vt][3] * rinv * gn[3] * sigmoidf_(bf_hi(o2.y)));
            *(u32x2*)(zrow + ZC_VM + v0) = r;
        }
    }
    __syncthreads();
}

#define XB_TMO      128
#define XB_XCNT(j)  (256  + 64 * (j))
#define XB_XSUB(j)  (1280 + 64 * (j))
#define XB_XGEN(j)  (2304 + 64 * (j))
#define XB_TOP      3328
#define XB_TOPGEN   3392
#define XCD_BAR_WORDS 3456
#define XB_SPIN_CAP (1u << 18)
__device__ __forceinline__ unsigned xb_ld(unsigned* p)              { return __hip_atomic_load(p, __ATOMIC_RELAXED, __HIP_MEMORY_SCOPE_AGENT); }
__device__ __forceinline__ unsigned xb_add(unsigned* p, unsigned v) { return __hip_atomic_fetch_add(p, v, __ATOMIC_RELAXED, __HIP_MEMORY_SCOPE_AGENT); }
__device__ __forceinline__ unsigned xb_xcc_id() { return (unsigned)__builtin_amdgcn_s_getreg((3 << 11) | 20) & 0xFu; }
#define XB_SPIN(cond, bar) do { unsigned _sp = 0; while (cond) { __builtin_amdgcn_s_sleep(1); \
    if ((++_sp & 255u) == 0u) { if (xb_ld(&(bar)[XB_TMO])) break; if (_sp > XB_SPIN_CAP) { atomicAdd(&(bar)[XB_TMO], 1u); break; } } } } while (0)
struct XcdBarrier { unsigned* bar; unsigned x; volatile LAS unsigned* st; };
__device__ __forceinline__ XcdBarrier xcd_barrier_post(unsigned* bar, volatile LAS unsigned* st) {
    XcdBarrier b; b.bar = bar; b.x = xb_xcc_id(); b.st = st;
    if (threadIdx.x == 0) (void)xb_add(&bar[XB_XCNT(b.x)], 1u);
    return b;
}
__device__ __forceinline__ void xcd_barrier_complete(unsigned* bar, unsigned x, unsigned& nloc, unsigned& nx) {
    const unsigned G = gridDim.x * gridDim.y * gridDim.z;
    unsigned sum, cnt, mine, sp = 0u;
    for (;;) {
        sum = 0u; cnt = 0u; mine = 0u;
#pragma unroll
        for (unsigned j = 0; j < 16; ++j) { const unsigned c = xb_ld(&bar[XB_XCNT(j)]); sum += c; cnt += (c > 0u) ? 1u : 0u; mine = (j == x) ? c : mine; }
        if (sum == G) break;
        __builtin_amdgcn_s_sleep(1);
        if ((++sp & 255u) == 0u) { if (xb_ld(&bar[XB_TMO])) break; if (sp > XB_SPIN_CAP) { atomicAdd(&bar[XB_TMO], 1u); break; } }
    }
    nloc = mine > 0u ? mine : 1u; nx = cnt > 0u ? cnt : 1u;
}
__device__ __forceinline__ void xcd_barrier(unsigned* bar, unsigned x, volatile LAS unsigned* st) {
    asm volatile("s_waitcnt vmcnt(0)" ::: "memory");
    __syncthreads();
    if (threadIdx.x == 0) {
        __builtin_amdgcn_s_waitcnt(0);
        unsigned nloc = st[0], nx = st[1];
        if (nloc == 0u) { xcd_barrier_complete(bar, x, nloc, nx); st[0] = nloc; st[1] = nx; }
        const unsigned old = xb_add(&bar[XB_XSUB(x)], 1u);
        const unsigned gen = old / nloc;
        if (old + 1u == (gen + 1u) * nloc) {
            __builtin_amdgcn_fence(__ATOMIC_RELEASE, "agent");
            asm volatile("s_waitcnt vmcnt(0)" ::: "memory");
            const unsigned og = xb_add(&bar[XB_TOP], 1u);
            const unsigned tg = og / nx;
            if (og + 1u == (tg + 1u) * nx) xb_add(&bar[XB_TOPGEN], 1u);
            else XB_SPIN(xb_ld(&bar[XB_TOPGEN]) == tg, bar);
            xb_add(&bar[XB_XGEN(x)], 1u);
            __builtin_amdgcn_fence(__ATOMIC_ACQUIRE, "agent");
            asm volatile("s_waitcnt vmcnt(0)" ::: "memory");
        } else {
            XB_SPIN(xb_ld(&bar[XB_XGEN(x)]) == gen, bar);
            __builtin_amdgcn_fence(__ATOMIC_ACQUIRE, "agent");
            asm volatile("s_waitcnt vmcnt(0)" ::: "memory");
        }
    }
    __syncthreads();
}

constexpr int PH_PER_LAYER = 9, N_PHASES = 1 + DEPTH * PH_PER_LAYER;

__global__ void __launch_bounds__(512, 2) fwd_kernel(Args Punused) {
    extern __shared__ __attribute__((aligned(16))) unsigned char lds_raw[];
    cg::grid_group grid = cg::this_grid();
    LAS unsigned char* ldsl = (LAS unsigned char*)lds_raw;
#define KP_DECL KArgs kp = (KArgs)__builtin_amdgcn_kernarg_segment_ptr(); asm volatile("" : "+s"(kp))
#define BST ((volatile LAS unsigned*)(ldsl + 131072))
    if (threadIdx.x < 4) BST[threadIdx.x] = 0u;
    __syncthreads();
#if MK_PER_PHASE_LAUNCH
    int lo, hi;
    { KP_DECL; lo = kp->ph_lo; hi = kp->ph_hi; }
#else
    constexpr int lo = 0, hi = N_PHASES;
    { KP_DECL; (void)xcd_barrier_post((unsigned*)(gptr(kp->ws) + WS_BAR), BST); }
#endif
#ifndef ONLY
#define ONLY -1
#endif
#define EN(n) (ONLY < 0 || ONLY == (n))
#define IN(k) (lo <= (k) && (k) < hi)
#define SYNC(k) do { if (IN((k) + 1)) { KP_DECL; xcd_barrier((unsigned*)(gptr(kp->ws) + WS_BAR), xb_xcc_id(), BST); } } while (0)
#define SYNC_CG(k) do { if (IN((k) + 1)) grid.sync(); } while (0)

    if (EN(0) && IN(0)) { KP_DECL; prologue(kp, lds_raw);
#if MK_PER_PHASE_LAUNCH
        SYNC_CG(0);
#else
        if (kp->ph_lo < 0) grid.sync();
        SYNC(0);
#endif
    }

#pragma unroll 1
    for (int l = 0; l < DEPTH; ++l) {
        const int p0 = 1 + l * PH_PER_LAYER;
        if (EN(1) && IN(p0 + 0)) {
            KP_DECL; unsigned char* ws = gptr(kp->ws); unsigned char* wl = ws + WS_W + (size_t)l * WL_SIZE;
            pg8::Gemm g{(const bf16_t*)(ws + WS_XB), (const bf16_t*)(wl + WL_IN), MROWS, ZP, DM, DM}; pg8::StaticOrder S; S.init(MROWS, ZP, (int)gridDim.x, (int)blockIdx.x);
            pg8::inv_prepass((LAS float*)(ldsl + pg8::LINV_OFF), (const float*)(ws + WS_RS), S);
            pg8::EpiScale<0> E{(bf16_t*)(ws + WS_Z), ZP, (const LAS float*)(ldsl + pg8::LINV_OFF), 17};
            pg8::gemm_phase(ldsl, g, S, E);
            SYNC(p0 + 0);
        }
        if (EN(2) && IN(p0 + 1)) {
            KP_DECL; unsigned char* ws = gptr(kp->ws); const int G = gridDim.x;
            bf16_t* Z = (bf16_t*)(ws + WS_Z);
            const int swap = (blockIdx.x >> 3) & 1;
#pragma unroll 1
            for (int pass = 0; pass < 2; ++pass) {
                if ((pass ^ swap) == 0) {
                    for (int it = blockIdx.x; it < 512; it += G) {
                        int item = it;
                        if (G == 256) { const int c = it & 255, p = (c & 7) + 8 * (it >> 8); item = ((p >> 1) << 6) | ((c >> 3) << 1) | (p & 1); }
                        attn_item(lds_raw, Z, (const f32x2*)(ws + WS_ROPE), gptr(kp->qn) + l * 64, gptr(kp->kn) + l * 64, gptr(kp->sinks) + l * 8, item);
                    }
                } else {
                    for (int it = blockIdx.x; it < BATCH * NCH; it += G) m1_item4(lds_raw, Z, gptr(kp->gbias) + l * 8, (bf16_t*)(ws + WS_DC), (float*)(ws + WS_DN), (float*)(ws + WS_G), (float*)(ws + WS_ML), it);
                }
            }
            SYNC(p0 + 1);
        }
        if (EN(3) && IN(p0 + 2)) {
            KP_DECL; unsigned char* ws = gptr(kp->ws); const int G = gridDim.x;
            for (int it = blockIdx.x; it < 256; it += G) scan_item(lds_raw, (unsigned*)(ws + WS_DC), (float*)(ws + WS_DN), (const float*)(ws + WS_G), (const float*)(ws + WS_ML), (float*)(ws + WS_MP), it);
            SYNC(p0 + 2);
        }
        if (EN(4) && IN(p0 + 3)) {
            KP_DECL; unsigned char* ws = gptr(kp->ws); const int G = gridDim.x;
            for (int it = blockIdx.x; it < BATCH * NCH * 2; it += G) m3_item(lds_raw, (bf16_t*)(ws + WS_Z), gptr(kp->gbias) + l * 8, gptr(kp->hn) + l * 512, (const bf16_t*)(ws + WS_DC), (const float*)(ws + WS_DN), (const float*)(ws + WS_MP), it);
            SYNC(p0 + 3);
        }
        if (EN(5) && IN(p0 + 4)) {
            KP_DECL; unsigned char* ws = gptr(kp->ws); unsigned char* wl = ws + WS_W + (size_t)l * WL_SIZE; bf16_t* Z = (bf16_t*)(ws + WS_Z);
            pg8::Gemm g{Z + ZC_QA, (const bf16_t*)(wl + WL_AB), MROWS, DM, 512, ZP}; pg8::StaticOrder S; S.init(MROWS, DM, (int)gridDim.x, (int)blockIdx.x);
            pg8::EpiGate<0> E{(bf16_t*)(ws + WS_DC), Z, ZC_GA};
            pg8::gemm_phase(ldsl, g, S, E);
            __syncthreads();
        }
        if (EN(6) && IN(p0 + 5)) {
            KP_DECL; unsigned char* ws = gptr(kp->ws); unsigned char* wl = ws + WS_W + (size_t)l * WL_SIZE; bf16_t* Z = (bf16_t*)(ws + WS_Z);
            pg8::Gemm g{Z + ZC_VM, (const bf16_t*)(wl + WL_MB), MROWS, DM, 512, ZP}; pg8::StaticOrder S; S.init(MROWS, DM, (int)gridDim.x, (int)blockIdx.x);
            pg8::EpiGate<1> E{(bf16_t*)(ws + WS_DC), Z, ZC_GM};
            pg8::gemm_phase(ldsl, g, S, E);
            SYNC(p0 + 5);
        }
        if (EN(7) && IN(p0 + 6)) {
            KP_DECL; unsigned char* ws = gptr(kp->ws); unsigned char* wl = ws + WS_W + (size_t)l * WL_SIZE;
            pg8::Gemm g{(const bf16_t*)(ws + WS_DC), (const bf16_t*)(wl + WL_OUT), MROWS, DM, DM, DM}; pg8::StaticOrder S; S.init(MROWS, DM, (int)gridDim.x, (int)blockIdx.x);
            pg8::EpiRes<0> E{gptr(kp->out), (bf16_t*)(ws + WS_XB), (float*)(ws + WS_RS)};
            pg8::gemm_phase(ldsl, g, S, E);
            SYNC(p0 + 6);
        }
        if (EN(8) && IN(p0 + 7)) {
            KP_DECL; unsigned char* ws = gptr(kp->ws); unsigned char* wl = ws + WS_W + (size_t)l * WL_SIZE;
            pg8::Gemm g{(const bf16_t*)(ws + WS_XB), (const bf16_t*)(wl + WL_1), MROWS, DFF, DM, DM}; pg8::StaticOrder S; S.init(MROWS, DFF, (int)gridDim.x, (int)blockIdx.x);
            pg8::inv_prepass((LAS float*)(ldsl + pg8::LINV_OFF), (const float*)(ws + WS_RS), S);
            pg8::EpiScale<1> E{(bf16_t*)(ws + WS_Z), DFF, (const LAS float*)(ldsl + pg8::LINV_OFF), -1};
            pg8::gemm_phase(ldsl, g, S, E);
            SYNC(p0 + 7);
        }
        if (EN(9) && IN(p0 + 8)) {
            KP_DECL; unsigned char* ws = gptr(kp->ws); unsigned char* wl = ws + WS_W + (size_t)l * WL_SIZE;
            pg8::Gemm g{(const bf16_t*)(ws + WS_Z), (const bf16_t*)(wl + WL_2), MROWS, DM, DFF, DFF}; pg8::StaticOrder S; S.init(MROWS, DM, (int)gridDim.x, (int)blockIdx.x);
            if (l == DEPTH - 1) { pg8::EpiRes<1> E{gptr(kp->out), (bf16_t*)(ws + WS_XB), (float*)(ws + WS_RS)}; pg8::gemm_phase(ldsl, g, S, E); }
            else { pg8::EpiRes<0> E{gptr(kp->out), (bf16_t*)(ws + WS_XB), (float*)(ws + WS_RS)}; pg8::gemm_phase(ldsl, g, S, E); }
            SYNC(p0 + 8);
        }
    }
#undef IN
#undef SYNC
}

extern "C" void kernel_launch(void* const* d_in, const int* in_sizes, int n_in, void* d_out, int out_size, void* d_ws, size_t ws_size, hipStream_t stream) {
    static int grid = 0;
    if (grid == 0) {
        if (n_in != 14 || in_sizes[0] != MROWS * DM || out_size != MROWS * DM || ws_size < WS_END) {
            fprintf(stderr, "kernel_launch: unexpected shapes / workspace (n_in %d, in0 %d, out %d, ws %zu); nothing launched\n", n_in, n_in > 0 ? in_sizes[0] : -1, out_size, ws_size); grid = -1; return; }
        int dev = 0, cus = 0, per_cu = 0;
        hipGetDevice(&dev); hipDeviceGetAttribute(&cus, hipDeviceAttributeMultiprocessorCount, dev);
        if (hipFuncSetAttribute((const void*)fwd_kernel, hipFuncAttributeMaxDynamicSharedMemorySize, LDS_BYTES) != hipSuccess) { fprintf(stderr, "kernel_launch: hipFuncSetAttribute failed\n"); grid = -1; return; }
        if (hipOccupancyMaxActiveBlocksPerMultiprocessor(&per_cu, (const void*)fwd_kernel, 512, LDS_BYTES) != hipSuccess || per_cu < 1) { fprintf(stderr, "kernel_launch: occupancy query failed (%d)\n", per_cu); per_cu = 1; (void)hipGetLastError(); }
        grid = cus * (per_cu > 1 ? 1 : per_cu);
        if (grid <= 0) { grid = -1; return; }
    }
    if (grid < 0) return;
    Args a{};
    a.x = (const float*)d_in[0]; a.norm_mix = (const float*)d_in[1]; a.w_in = (const float*)d_in[2]; a.qn = (const float*)d_in[3]; a.kn = (const float*)d_in[4];
    a.sinks = (const float*)d_in[5]; a.gbias = (const float*)d_in[6]; a.hn = (const float*)d_in[7]; a.w_ab = (const float*)d_in[8]; a.w_mb = (const float*)d_in[9];
    a.w_out = (const float*)d_in[10]; a.norm_ffn = (const float*)d_in[11]; a.w1 = (const float*)d_in[12]; a.w2 = (const float*)d_in[13];
    a.out = (float*)d_out; a.ws = (unsigned char*)d_ws;
    for (int i = 0; i < 8; ++i) a.inv_freq[i] = (float)pow(500000.0, -(double)(2 * i) / 16.0);
#if MK_PER_PHASE_LAUNCH
    for (int p = 0; p < N_PHASES; ++p) {
        a.ph_lo = p; a.ph_hi = p + 1;
        hipLaunchKernelGGL(fwd_kernel, dim3(grid), dim3(512), LDS_BYTES, stream, a);
    }
#else
    a.ph_lo = 0; a.ph_hi = N_PHASES;
    if (hipMemsetAsync((char*)d_ws + WS_BAR, 0, 16384, stream) != hipSuccess) { fprintf(stderr, "kernel_launch: memset of barrier words failed\n"); return; }
    void* args[] = {&a};
    hipError_t e = hipLaunchCooperativeKernel((const void*)fwd_kernel, dim3(grid), dim3(512), args, LDS_BYTES, stream);
    if (e != hipSuccess) fprintf(stderr, "cooperative launch failed: %s (grid %d)\n", hipGetErrorString(e), grid);
#endif
}
```

```cpp
#include <hip/hip_runtime.h>
#include <hip/hip_cooperative_groups.h>
#include <cstdio>
#include <cstdint>
#include <cmath>
namespace cg = cooperative_groups;

#ifndef MK_PER_PHASE_LAUNCH
#define MK_PER_PHASE_LAUNCH 0
#endif

#define LAS __attribute__((address_space(3)))
typedef unsigned short bf16_t;
typedef short bf16x8 __attribute__((ext_vector_type(8)));
typedef float f32x4 __attribute__((ext_vector_type(4)));
typedef float f32x2 __attribute__((ext_vector_type(2)));
typedef unsigned u32x4 __attribute__((ext_vector_type(4)));
typedef unsigned u32x2 __attribute__((ext_vector_type(2)));

constexpr int DM = 1024, BATCH = 8, SEQ = 4096, MROWS = BATCH * SEQ, DFF = 4096, DEPTH = 2;
constexpr int ZP = 4608;
constexpr int ZC_QA = 0, ZC_KA = 512, ZC_VA = 640, ZC_QM = 768, ZC_KM = 1024, ZC_VM = 1280, ZC_OM = 1792, ZC_GA = 2304, ZC_GM = 3328, ZC_IF = 4352;
constexpr int DIN_SRC = 4360;
constexpr float EPS = 1e-6f;
constexpr int NCH = 64;
constexpr int NITEM_M = BATCH * NCH * 4;

constexpr size_t MiB = 1u << 20;
constexpr size_t WS_RS = 0;
constexpr size_t WS_ROPE = 2 * MiB;
constexpr size_t WS_DN = 3 * MiB;
constexpr size_t WS_G = 4 * MiB;
constexpr size_t WS_ML = 4 * MiB + 65536;
constexpr size_t WS_MP = 4 * MiB + 131072;
constexpr size_t WS_W = 8 * MiB;
constexpr size_t WL_IN = 0, WL_AB = 9 * MiB, WL_MB = 10 * MiB, WL_OUT = 11 * MiB, WL_1 = 13 * MiB, WL_2 = 21 * MiB, WL_SIZE = 29 * MiB;
constexpr size_t WS_XB = 66 * MiB;
constexpr size_t WS_Z = 130 * MiB;
constexpr size_t WS_DC = 418 * MiB;
constexpr size_t WS_END = 482 * MiB;

constexpr int LDS_BYTES = 131072 + 64 + 9 * 256 * 4;
constexpr size_t WS_BAR = 5 * MiB;

#define GAS __attribute__((address_space(1)))
template <class T> __device__ __forceinline__ T* gptr(T* p) { return (T*)(GAS T*)p; }
__device__ __forceinline__ unsigned pk_bf16(float lo, float hi) {
    typedef __bf16 b2 __attribute__((ext_vector_type(2)));
    f32x2 v = {lo, hi}; b2 r = __builtin_convertvector(v, b2); return __builtin_bit_cast(unsigned, r);
}
__device__ __forceinline__ float bf_lo(unsigned u) { return __uint_as_float(u << 16); }
__device__ __forceinline__ float bf_hi(unsigned u) { return __uint_as_float(u & 0xffff0000u); }
__device__ __forceinline__ float bf2f(bf16_t v) { return __uint_as_float(((unsigned)v) << 16); }
__device__ __forceinline__ float sigmoidf_(float x) { return __builtin_amdgcn_rcpf(1.0f + __expf(-x)); }
__device__ __forceinline__ float xsum16(float v) { const auto r = __builtin_amdgcn_permlane16_swap(__float_as_uint(v), __float_as_uint(v), false, false); return __uint_as_float(r[0]) + __uint_as_float(r[1]); }
__device__ __forceinline__ float xsum32(float v) { const auto r = __builtin_amdgcn_permlane32_swap(__float_as_uint(v), __float_as_uint(v), false, false); return __uint_as_float(r[0]) + __uint_as_float(r[1]); }
__device__ __forceinline__ float xmax16(float v) { const auto r = __builtin_amdgcn_permlane16_swap(__float_as_uint(v), __float_as_uint(v), false, false); return fmaxf(__uint_as_float(r[0]), __uint_as_float(r[1])); }
__device__ __forceinline__ float xmax32(float v) { const auto r = __builtin_amdgcn_permlane32_swap(__float_as_uint(v), __float_as_uint(v), false, false); return fmaxf(__uint_as_float(r[0]), __uint_as_float(r[1])); }
__device__ __forceinline__ float rowsum4(float v) { return xsum32(xsum16(v)); }
__device__ __forceinline__ float rowmax4(float v) { return xmax32(xmax16(v)); }
__device__ __forceinline__ float wave_sum(float v) {
#pragma unroll
    for (int o = 1; o < 64; o <<= 1) v += __shfl_xor(v, o);
    return v;
}
__device__ __forceinline__ float wave_max(float v) {
#pragma unroll
    for (int o = 1; o < 64; o <<= 1) v = fmaxf(v, __shfl_xor(v, o));
    return v;
}

#ifndef PG8_ALIGN
#define PG8_ALIGN 1
#endif
namespace pg8 {
constexpr int BM = 256, BK = 64, HALF = 128, HTB = HALF * BK * 2, NXCD = 8, WGM = 4;
__device__ __forceinline__ int lds_byte(int r, int c) { const int st = (r >> 4) * 2 + (c >> 5), rr = r & 15, cc = c & 31, ob = rr * 64 + cc * 2; return st * 1024 + (ob ^ (((ob >> 9) & 1) << 5)); }
__device__ __forceinline__ void stage_rc(int b, int& R, int& C) { const int st = b / 1024, sb = b % 1024, swz = sb ^ (((sb >> 9) & 1) << 5); R = (st >> 1) * 16 + swz / 64; C = (st & 1) * 32 + (swz % 64) / 2; }
__device__ __forceinline__ int perm32(int rho) { const int n = rho >> 4, i = rho & 15; return 8 * (i >> 2) + 4 * n + (i & 3); }

struct Unit { int pm, pn, idx; };
struct Gemm { const bf16_t* A; const bf16_t* Bt; int M, N, K, lda, atiled; };

struct StaticOrder {
    int nM, nN, nwg, G, c;
    __device__ void init(int M, int N, int G_, int c_) { nM = M / BM; nN = N / BM; nwg = nM * nN; G = G_; c = c_; }
    __device__ bool next(int i, Unit& u) const {
        const long L = (long)i * G + c; if (L >= nwg) return false;
        int wgid = (int)L; { const int q = nwg / NXCD, r = nwg % NXCD, xcd = wgid % NXCD, off = wgid / NXCD; wgid = (xcd < r ? xcd * (q + 1) : r * (q + 1) + (xcd - r) * q) + off; }
        const int nig = WGM * nN, gid = wgid / nig, fm = gid * WGM, gsz = (nM - fm) < WGM ? (nM - fm) : WGM;
        u.pm = fm + ((wgid % nig) % gsz); u.pn = (wgid % nig) / gsz; u.idx = i; return true;
    }
};

template <class Epi>
__device__ __forceinline__ void gemm_phase(LAS unsigned char* lds, const Gemm g, const StaticOrder& S, const Epi& E) {
    int tid_ = threadIdx.x; asm volatile("" : "+v"(tid_));
    const int tid = tid_, wid = __builtin_amdgcn_readfirstlane(tid >> 6), lane = tid & 63, wr = wid >> 2, wc = wid & 3, fr = lane & 15, fq = lane >> 4;
    const int K = g.K, nt = K / BK, lda = g.lda;
    unsigned voffA[2], voffB[2];
#pragma unroll
    for (int i = 0; i < 2; ++i) { int R, C; stage_rc(tid * 16 + i * 8192, R, C); const int Rb = Epi::PERM ? ((R & ~31) + perm32(R & 31)) : R;
        voffA[i] = (unsigned)(R * lda + C) * 2u; voffB[i] = (unsigned)(Rb * K + C) * 2u; }
    const size_t kstep = (size_t)(BK * 2);
    const size_t kstepA = g.atiled ? (size_t)BM * BK * 2 : kstep;
    const size_t hstepA = (size_t)HALF * lda * 2, hstepB = (size_t)HALF * K * 2;
    const size_t tstepA = g.atiled ? (size_t)BM * K * 2 : 2 * hstepA, tstepB = 2 * hstepB;
    const unsigned ldsw = (unsigned)wid * 1024u;
    const int aoff = lds_byte(wr * 64 + fr, fq * 8), boff = lds_byte(wc * 32 + fr, fq * 8);
#define PG8_SA(b, h) (((b) * 2 + (h)) * HTB)
#define PG8_SB(b, h) ((4 + (b) * 2 + (h)) * HTB)
#define PG8_STAGE(bufoff, gbase, voff) do { _Pragma("unroll") for (int _i = 0; _i < 2; ++_i) \
        __builtin_amdgcn_global_load_lds((const unsigned*)((const char*)(gbase) + (voff)[_i]), (LAS unsigned*)(lds + (bufoff) + ldsw + _i * 8192), 16, 0, 0); } while (0)
#define PG8_LDA(dst, b, h) do { _Pragma("unroll") for (int m = 0; m < 4; ++m) _Pragma("unroll") for (int k = 0; k < 2; ++k) dst[m][k] = *(const LAS bf16x8*)(lds + PG8_SA(b, h) + aoff + m * 2048 + k * 1024); } while (0)
#define PG8_LDB(dst, b, h) do { _Pragma("unroll") for (int n = 0; n < 2; ++n) _Pragma("unroll") for (int k = 0; k < 2; ++k) dst[n][k] = *(const LAS bf16x8*)(lds + PG8_SB(b, h) + boff + n * 2048 + k * 1024); } while (0)
#define PG8_MMA(ai, bj, At, Bt) do { __builtin_amdgcn_s_setprio(1); _Pragma("unroll") for (int k = 0; k < 2; ++k) _Pragma("unroll") for (int m = 0; m < 4; ++m) _Pragma("unroll") for (int n = 0; n < 2; ++n) \
        acc[ai][bj][m][n] = __builtin_amdgcn_mfma_f32_16x16x32_bf16(Bt[n][k], At[m][k], acc[ai][bj][m][n], 0, 0, 0); __builtin_amdgcn_s_setprio(0); } while (0)
#define PG8_WAIT_V(n) asm volatile("s_waitcnt vmcnt(" #n ")" ::: "memory")
#define PG8_WAIT_L(n) asm volatile("s_waitcnt lgkmcnt(" #n ")" ::: "memory")
#define PG8_BAR __builtin_amdgcn_s_barrier()
#define PG8_SCHED __builtin_amdgcn_sched_barrier(0)
    Unit cur, nxt; int ui = 0;
    if (!S.next(0, cur)) return;
    f32x4 acc[2][2][4][2];
#pragma unroll
    for (int a = 0; a < 2; ++a)
#pragma unroll
        for (int b = 0; b < 2; ++b)
#pragma unroll
            for (int m = 0; m < 4; ++m)
#pragma unroll
                for (int n = 0; n < 2; ++n) acc[a][b][m][n] = (f32x4){0.f, 0.f, 0.f, 0.f};
    bf16x8 At[4][2], B0[2][2], B1[2][2];
    const char* cA = (const char*)g.A + (size_t)cur.pm * tstepA; const char* cB = (const char*)g.Bt + (size_t)cur.pn * tstepB;
    PG8_STAGE(PG8_SB(0, 0), cB, voffB); PG8_STAGE(PG8_SB(0, 1), cB + hstepB, voffB); PG8_STAGE(PG8_SA(0, 0), cA, voffA); PG8_STAGE(PG8_SA(0, 1), cA + hstepA, voffA);
    if (wr == 1) PG8_BAR;
    PG8_WAIT_V(2); PG8_BAR;
    PG8_STAGE(PG8_SB(1, 0), cB + kstep, voffB); PG8_STAGE(PG8_SA(1, 0), cA + kstepA, voffA); PG8_STAGE(PG8_SB(1, 1), cB + hstepB + kstep, voffB);
    PG8_WAIT_V(6); PG8_BAR;
    for (;;) {
        const bool has_next = S.next(ui + 1, nxt);
        const char* nA = has_next ? (const char*)g.A + (size_t)nxt.pm * tstepA : cA; const char* nB = has_next ? (const char*)g.Bt + (size_t)nxt.pn * tstepB : cB;
        for (int t = 0; t < nt; t += 2) {
            const bool last = (t == nt - 2);
            const char* a1 = cA + (size_t)(t + 1) * kstepA;
            const char* a2 = last ? nA : cA + (size_t)(t + 2) * kstepA; const char* b2 = last ? nB : cB + (size_t)(t + 2) * kstep;
            const char* a3 = a2 + kstepA; const char* b3 = b2 + kstep;
            PG8_LDB(B0, 0, 0); PG8_LDB(B1, 0, 1); PG8_SCHED; PG8_LDA(At, 0, 0); PG8_STAGE(PG8_SA(1, 1), a1 + hstepA, voffA);
            PG8_WAIT_V(8); PG8_WAIT_L(0); PG8_BAR; PG8_MMA(0, 0, At, B0); PG8_MMA(0, 1, At, B1); PG8_BAR; PG8_SCHED;
            PG8_LDA(At, 0, 1); PG8_STAGE(PG8_SB(0, 0), b2, voffB); PG8_STAGE(PG8_SB(0, 1), b2 + hstepB, voffB); PG8_STAGE(PG8_SA(0, 0), a2, voffA);
            PG8_WAIT_V(8); PG8_WAIT_L(0); PG8_BAR; PG8_MMA(1, 0, At, B0); PG8_MMA(1, 1, At, B1); PG8_BAR; PG8_SCHED;
            PG8_LDB(B0, 1, 0); PG8_LDB(B1, 1, 1); PG8_SCHED; PG8_LDA(At, 1, 0); PG8_STAGE(PG8_SA(0, 1), a2 + hstepA, voffA);
            PG8_WAIT_V(8); PG8_WAIT_L(0); PG8_BAR; PG8_MMA(0, 0, At, B0); PG8_MMA(0, 1, At, B1); PG8_BAR; PG8_SCHED;
            PG8_LDA(At, 1, 1); PG8_STAGE(PG8_SB(1, 0), b3, voffB); PG8_STAGE(PG8_SB(1, 1), b3 + hstepB, voffB); PG8_STAGE(PG8_SA(1, 0), a3, voffA);
            PG8_WAIT_V(8); PG8_WAIT_L(0); PG8_BAR; PG8_MMA(1, 0, At, B0); PG8_MMA(1, 1, At, B1); PG8_BAR; PG8_SCHED;
        }
        if (PG8_ALIGN) { if (wr == 0) PG8_BAR; }
        E(acc, cur, wr, wc, fr, fq);
        if (!has_next) break;
#pragma unroll
        for (int a = 0; a < 2; ++a)
#pragma unroll
            for (int b = 0; b < 2; ++b)
#pragma unroll
                for (int m = 0; m < 4; ++m)
#pragma unroll
                    for (int n = 0; n < 2; ++n) acc[a][b][m][n] = (f32x4){0.f, 0.f, 0.f, 0.f};
        cur = nxt; cA = nA; cB = nB; ++ui;
        if (PG8_ALIGN) { if (wr == 1) PG8_BAR; }
    }
    PG8_WAIT_V(0);
    if (!PG8_ALIGN) { if (wr == 0) PG8_BAR; }
    PG8_BAR;
#undef PG8_SA
#undef PG8_SB
#undef PG8_STAGE
#undef PG8_LDA
#undef PG8_LDB
#undef PG8_MMA
#undef PG8_WAIT_V
#undef PG8_WAIT_L
#undef PG8_BAR
#undef PG8_SCHED
}

constexpr int LINV_OFF = 131072 + 64, LINV_UNITS = 9;
template <int ACT> struct EpiScale {
    static constexpr bool PERM = true;
    bf16_t* O; int ldc; const LAS float* linv; int pad_tile; int otiled;
    __device__ __forceinline__ void operator()(const f32x4 (&acc)[2][2][4][2], const Unit& u, int wr, int wc, int fr, int fq) const {
        const int row0 = u.pm * BM + wr * 64 + fr, col0 = u.pn * BM + wc * 32 + 8 * fq;
        const LAS float* li = linv + u.idx * 256 + wr * 64 + fr;
#pragma unroll
        for (int ai = 0; ai < 2; ++ai)
#pragma unroll
            for (int m = 0; m < 4; ++m) {
                const int row = row0 + ai * HALF + m * 16;
                const float inv = li[ai * HALF + m * 16];
                bf16_t* rowp = otiled ? O + ((size_t)(u.pm * (ldc >> 6) + (col0 >> 6)) * BM + (row & (BM - 1))) * 64 + (col0 & 63) : O + (size_t)row * ldc + col0;
                const int bjstep = otiled ? 2 * BM * 64 : HALF;
#pragma unroll
                for (int bj = 0; bj < 2; ++bj) {
                    f32x4 v0 = acc[ai][bj][m][0] * inv, v1 = acc[ai][bj][m][1] * inv;
                    if (ACT == 1) {
#pragma unroll
                        for (int e = 0; e < 4; ++e) { const float a = fmaxf(v0[e], 0.f), b = fmaxf(v1[e], 0.f); v0[e] = a * a; v1[e] = b * b; }
                    }
                    u32x4 w; w.x = pk_bf16(v0[0], v0[1]); w.y = pk_bf16(v0[2], v0[3]); w.z = pk_bf16(v1[0], v1[1]); w.w = pk_bf16(v1[2], v1[3]);
                    if (u.pn != pad_tile || (bj == 0 && wc == 0 && fq == 0)) *(u32x4*)(rowp + bj * bjstep) = w;
                }
            }
    }
};
__device__ __forceinline__ void inv_prepass(LAS float* linv, const float* rs, const StaticOrder& S) {
    int tid_ = threadIdx.x; asm volatile("" : "+v"(tid_));
    const int r = tid_ & 255, par = tid_ >> 8;
    f32x4 p[5][4]; Unit u;
#pragma unroll
    for (int k = 0; k < 5; ++k) {
        const int i = 2 * k + par;
        const bool ok = (i < LINV_UNITS) && S.next(i, u);
#pragma unroll
        for (int q = 0; q < 4; ++q) p[k][q] = ok ? *(const f32x4*)(rs + (size_t)(u.pm * BM + r) * 16 + 4 * q) : (f32x4){0.f, 0.f, 0.f, 0.f};
    }
#pragma unroll
    for (int k = 0; k < 5; ++k) {
        const int i = 2 * k + par;
        if (i < LINV_UNITS) {
            const f32x4 t = (p[k][0] + p[k][1]) + (p[k][2] + p[k][3]);
            linv[i * 256 + r] = rsqrtf(((t[0] + t[1]) + (t[2] + t[3])) * (1.0f / 1024.0f) + EPS);
        }
    }
    __syncthreads();
}
template <int ADD> struct EpiGate {
    static constexpr bool PERM = true;
    bf16_t* O; const bf16_t* Z; int gcol;
    __device__ __forceinline__ void operator()(const f32x4 (&acc)[2][2][4][2], const Unit& u, int wr, int wc, int fr, int fq) const {
        const int row0 = u.pm * BM + wr * 64 + fr, col0 = u.pn * BM + wc * 32 + 8 * fq;
        u32x4 gq[4][2], tq[4][2];
#define EG_LOAD(ai, m) do { _Pragma("unroll") for (int bj = 0; bj < 2; ++bj) { const int row = row0 + (ai) * HALF + (m) * 16, col = col0 + bj * HALF; \
            gq[m][bj] = *(const u32x4*)(Z + (size_t)row * ZP + gcol + col); \
            if (ADD) tq[m][bj] = *(const u32x4*)(O + (size_t)row * DM + col); else tq[m][bj] = (u32x4){0u, 0u, 0u, 0u}; } } while (0)
#pragma unroll
        for (int m = 0; m < 4; ++m) EG_LOAD(0, m);
        asm volatile("" ::: "memory");
#pragma unroll
        for (int ai = 0; ai < 2; ++ai)
#pragma unroll
            for (int m = 0; m < 4; ++m) {
#pragma unroll
                for (int bj = 0; bj < 2; ++bj) {
                    const int row = row0 + ai * HALF + m * 16, col = col0 + bj * HALF;
                    const u32x4 g = gq[m][bj], t = tq[m][bj];
                    const f32x4 a0 = acc[ai][bj][m][0], a1 = acc[ai][bj][m][1];
                    u32x4 w;
                    w.x = pk_bf16(bf_lo(t.x) + sigmoidf_(bf_lo(g.x)) * a0[0], bf_hi(t.x) + sigmoidf_(bf_hi(g.x)) * a0[1]);
                    w.y = pk_bf16(bf_lo(t.y) + sigmoidf_(bf_lo(g.y)) * a0[2], bf_hi(t.y) + sigmoidf_(bf_hi(g.y)) * a0[3]);
                    w.z = pk_bf16(bf_lo(t.z) + sigmoidf_(bf_lo(g.z)) * a1[0], bf_hi(t.z) + sigmoidf_(bf_hi(g.z)) * a1[1]);
                    w.w = pk_bf16(bf_lo(t.w) + sigmoidf_(bf_lo(g.w)) * a1[2], bf_hi(t.w) + sigmoidf_(bf_hi(g.w)) * a1[3]);
                    *(u32x4*)(O + (size_t)row * DM + col) = w;
                }
                asm volatile("" ::: "memory");
                if (ai == 0) { EG_LOAD(1, m); asm volatile("" ::: "memory"); }
            }
#undef EG_LOAD
    }
};
template <int FINAL> struct EpiRes {
    static constexpr bool PERM = true;
    float* out; bf16_t* xb; float* rs;
    __device__ __forceinline__ void operator()(const f32x4 (&acc)[2][2][4][2], const Unit& u, int wr, int wc, int fr, int fq) const {
        const int row0 = u.pm * BM + wr * 64 + fr, col0 = u.pn * BM + wc * 32 + 8 * fq;
        u32x4 pre[4][2];
#define ER_LOAD(ai, m) do { _Pragma("unroll") for (int bj = 0; bj < 2; ++bj) pre[m][bj] = *(const u32x4*)(xb + (size_t)(row0 + (ai) * HALF + (m) * 16) * DM + col0 + bj * HALF); } while (0)
#pragma unroll
        for (int m = 0; m < 4; ++m) ER_LOAD(0, m);
        asm volatile("" ::: "memory");
#pragma unroll
        for (int ai = 0; ai < 2; ++ai)
#pragma unroll
            for (int m = 0; m < 4; ++m) {
                const int row = row0 + ai * HALF + m * 16; float ss = 0.f;
#pragma unroll
                for (int bj = 0; bj < 2; ++bj) {
                    const size_t off = (size_t)row * DM + col0 + bj * HALF;
                    const u32x4 b = pre[m][bj];
                    const f32x4 v0 = (f32x4){bf_lo(b.x), bf_hi(b.x), bf_lo(b.y), bf_hi(b.y)} + acc[ai][bj][m][0];
                    const f32x4 v1 = (f32x4){bf_lo(b.z), bf_hi(b.z), bf_lo(b.w), bf_hi(b.w)} + acc[ai][bj][m][1];
                    if (FINAL) { *(f32x4*)(out + off) = v0; *(f32x4*)(out + off + 4) = v1; }
                    else {
                        u32x4 w; w.x = pk_bf16(v0[0], v0[1]); w.y = pk_bf16(v0[2], v0[3]); w.z = pk_bf16(v1[0], v1[1]); w.w = pk_bf16(v1[2], v1[3]);
                        *(u32x4*)(xb + off) = w;
                        ss += (v0[0] * v0[0] + v0[1] * v0[1]) + (v0[2] * v0[2] + v0[3] * v0[3]) + (v1[0] * v1[0] + v1[1] * v1[1]) + (v1[2] * v1[2] + v1[3] * v1[3]);
                    }
                }
                if (!FINAL) {
                    ss = rowsum4(ss);
                    if (fq == 0) rs[(size_t)row * 16 + u.pn * 4 + wc] = ss;
                }
                asm volatile("" ::: "memory");
                if (ai == 0) { ER_LOAD(1, m); asm volatile("" ::: "memory"); }
            }
#undef ER_LOAD
    }
};
}

struct Args {
    const float* x; const float* norm_mix; const float* w_in; const float* qn; const float* kn; const float* sinks; const float* gbias;
    const float* hn; const float* w_ab; const float* w_mb; const float* w_out; const float* norm_ffn; const float* w1; const float* w2;
    float* out; unsigned char* ws;
    float inv_freq[8];
    int ph_lo, ph_hi;
};

typedef const __attribute__((address_space(4))) Args* KArgs;
__device__ __forceinline__ int win_map(int n) { if (n < 2304) return n; if (n < 4352) return n + 8; if (n < 4360) return n - 2048; return -1; }

__device__ __forceinline__ void tr_item(const float* W, const float* gain, bf16_t* dst, int K, int Nsrc, int mode, int item, int nNb, float* s) {
    int tid_ = threadIdx.x; asm volatile("" : "+v"(tid_));
    const int tid = tid_; const int kb = item / nNb, nb = item % nNb;
    {
        const int c = tid & 255, r0 = tid >> 8; const int nd = nb * 256 + c; const int ns = mode ? win_map(nd) : nd;
        float v[32];
#pragma unroll
        for (int i = 0; i < 32; ++i) { const int k = kb * 64 + r0 + 2 * i; v[i] = (ns >= 0) ? W[(size_t)k * Nsrc + ns] : 0.f; }
        if (gain) {
#pragma unroll
            for (int i = 0; i < 32; ++i) v[i] *= gain[kb * 64 + r0 + 2 * i];
        }
#pragma unroll
        for (int i = 0; i < 32; ++i) s[c * 65 + r0 + 2 * i] = v[i];
    }
    __syncthreads();
    {
        const int kp = (tid & 31) * 2, r = tid >> 5;
#pragma unroll
        for (int i = 0; i < 16; ++i) {
            const int n = r + 16 * i;
            *(unsigned*)(dst + (size_t)(nb * 256 + n) * K + kb * 64 + kp) = pk_bf16(s[n * 65 + kp], s[n * 65 + kp + 1]);
        }
    }
    __syncthreads();
}

__device__ __forceinline__ void sincos_acc(double a, float& c, float& s) {
    const double q = rint(a * 0.63661977236758134308); const double r = a - q * 1.57079632679489661923; const int qi = ((int)q) & 3;
    const double r2 = r * r;
    const double sn = r * (1.0 + r2 * (-1.0 / 6.0 + r2 * (1.0 / 120.0 + r2 * (-1.0 / 5040.0 + r2 * (1.0 / 362880.0 + r2 * (-1.0 / 39916800.0))))));
    const double cs = 1.0 + r2 * (-0.5 + r2 * (1.0 / 24.0 + r2 * (-1.0 / 720.0 + r2 * (1.0 / 40320.0 + r2 * (-1.0 / 3628800.0 + r2 * (1.0 / 479001600.0))))));
    if (qi == 0) { c = (float)cs; s = (float)sn; } else if (qi == 1) { c = (float)(-sn); s = (float)cs; } else if (qi == 2) { c = (float)(-cs); s = (float)(-sn); } else { c = (float)sn; s = (float)(-cs); }
}

__device__ __forceinline__ void prologue(KArgs P, unsigned char* lds) {
    int tid_ = threadIdx.x; asm volatile("" : "+v"(tid_));
    const int tid = tid_, lane = tid & 63, wave = tid >> 6, G = gridDim.x;
    float* s = (float*)lds;
    constexpr int I_IN = 16 * 18, I_AB = 8 * 4, I_MB = 8 * 4, I_OUT = 16 * 4, I_1 = 16 * 16, I_2 = 64 * 4, I_L = I_IN + I_AB + I_MB + I_OUT + I_1 + I_2;
    for (int it = blockIdx.x; it < DEPTH * I_L; it += G) {
        const int l = it / I_L; int r = it % I_L;
        unsigned char* wl = gptr(P->ws) + WS_W + (size_t)l * WL_SIZE;
        if (r < I_IN) { tr_item(gptr(P->w_in) + (size_t)l * DM * DIN_SRC, gptr(P->norm_mix) + l * DM, (bf16_t*)(wl + WL_IN), DM, DIN_SRC, 1, r, 18, s); continue; } r -= I_IN;
        if (r < I_AB) { tr_item(gptr(P->w_ab) + (size_t)l * 512 * DM, nullptr, (bf16_t*)(wl + WL_AB), 512, DM, 0, r, 4, s); continue; } r -= I_AB;
        if (r < I_MB) { tr_item(gptr(P->w_mb) + (size_t)l * 512 * DM, nullptr, (bf16_t*)(wl + WL_MB), 512, DM, 0, r, 4, s); continue; } r -= I_MB;
        if (r < I_OUT) { tr_item(gptr(P->w_out) + (size_t)l * DM * DM, nullptr, (bf16_t*)(wl + WL_OUT), DM, DM, 0, r, 4, s); continue; } r -= I_OUT;
        if (r < I_1) { tr_item(gptr(P->w1) + (size_t)l * DM * DFF, gptr(P->norm_ffn) + l * DM, (bf16_t*)(wl + WL_1), DM, DFF, 0, r, 16, s); continue; } r -= I_1;
        tr_item(gptr(P->w2) + (size_t)l * DFF * DM, nullptr, (bf16_t*)(wl + WL_2), DFF, DM, 0, r, 4, s);
    }
    {
        bf16_t* xb = (bf16_t*)(gptr(P->ws) + WS_XB); float* rs = (float*)(gptr(P->ws) + WS_RS);
        const int gw = blockIdx.x * 8 + wave, NGW = G * 8;
        for (int row0 = gw * 4; row0 < MROWS; row0 += NGW * 4) {
            f32x4 v[4][4];
#pragma unroll
            for (int rr = 0; rr < 4; ++rr) { const f32x4* xr = (const f32x4*)(gptr(P->x) + (size_t)(row0 + rr) * DM) + lane;
#pragma unroll
                for (int j = 0; j < 4; ++j) v[rr][j] = xr[64 * j]; }
#pragma unroll
            for (int rr = 0; rr < 4; ++rr) {
                const int row = row0 + rr; float ss = 0.f;
#pragma unroll
                for (int j = 0; j < 4; ++j) ss += (v[rr][j][0] * v[rr][j][0] + v[rr][j][1] * v[rr][j][1]) + (v[rr][j][2] * v[rr][j][2] + v[rr][j][3] * v[rr][j][3]);
                ss = wave_sum(ss);
                u32x2* o = (u32x2*)(xb + (size_t)row * DM) + lane;
#pragma unroll
                for (int j = 0; j < 4; ++j) { u32x2 w; w.x = pk_bf16(v[rr][j][0], v[rr][j][1]); w.y = pk_bf16(v[rr][j][2], v[rr][j][3]); o[64 * j] = w; }
                if (lane < 4) { f32x4 z = {0.f, 0.f, 0.f, 0.f}; if (lane == 0) z[0] = ss; *((f32x4*)(rs + (size_t)row * 16) + lane) = z; }
            }
        }
    }
    {
        f32x2* rope = (f32x2*)(gptr(P->ws) + WS_ROPE);
        for (int e = blockIdx.x * 512 + tid; e < SEQ * 8; e += G * 512) {
            const int pos = e >> 3, i = e & 7; const float ang = (float)pos * P->inv_freq[i];
            float c, sn; sincos_acc((double)ang, c, sn); rope[e] = (f32x2){c, sn};
        }
    }
}

__device__ __forceinline__ void attn_item(unsigned char* lds, bf16_t* Z, const f32x2* rope, const float* qn, const float* kn, const float* sinks, int item) {
    int tid_ = threadIdx.x; asm volatile("" : "+v"(tid_));
    const int tid = tid_, lane = tid & 63, w = __builtin_amdgcn_readfirstlane(tid >> 6), l15 = lane & 15, g = lane >> 4;
    const int kvh = item & 1, n = (item >> 1) & 31, b = item >> 6;
    bf16_t* Ks = (bf16_t*)lds;
    bf16_t* VT = (bf16_t*)(lds + 256 * 144);
    const size_t rowbase = (size_t)b * SEQ;
    const int pos0 = 128 * (n - 1);
    const int qpos = 128 * n + 16 * w + l15;
    const size_t grow = rowbase + qpos;
    u32x4 qn0, qn1;
    { const bf16_t* q0 = Z + grow * ZP + ZC_QA + (kvh * 4) * 64 + 8 * g; qn0 = *(const u32x4*)(q0); qn1 = *(const u32x4*)(q0 + 32); }
    if (tid < 256) {
        const int key = tid, pos = pos0 + key;
        u32x4 raw[8];
        if (pos >= 0) {
            const u32x4* src = (const u32x4*)(Z + (rowbase + pos) * ZP + ZC_KA + kvh * 64);
#pragma unroll
            for (int i = 0; i < 8; ++i) raw[i] = src[i];
        } else {
#pragma unroll
            for (int i = 0; i < 8; ++i) raw[i] = (u32x4){0u, 0u, 0u, 0u};
        }
        float ss = 0.f;
#pragma unroll
        for (int i = 0; i < 8; ++i) { const u32x4 r = raw[i];
            ss += bf_lo(r.x) * bf_lo(r.x) + bf_hi(r.x) * bf_hi(r.x) + bf_lo(r.y) * bf_lo(r.y) + bf_hi(r.y) * bf_hi(r.y) + bf_lo(r.z) * bf_lo(r.z) + bf_hi(r.z) * bf_hi(r.z) + bf_lo(r.w) * bf_lo(r.w) + bf_hi(r.w) * bf_hi(r.w); }
        const float inv = rsqrtf(ss * (1.0f / 64.0f) + EPS);
        const int pp = pos >= 0 ? pos : 0;
        u32x4* dst = (u32x4*)(Ks + key * 72);
        {
            float a[8], bq[8];
            { const u32x4 r = raw[0]; a[0] = bf_lo(r.x); a[1] = bf_hi(r.x); a[2] = bf_lo(r.y); a[3] = bf_hi(r.y); a[4] = bf_lo(r.z); a[5] = bf_hi(r.z); a[6] = bf_lo(r.w); a[7] = bf_hi(r.w); }
            { const u32x4 r = raw[1]; bq[0] = bf_lo(r.x); bq[1] = bf_hi(r.x); bq[2] = bf_lo(r.y); bq[3] = bf_hi(r.y); bq[4] = bf_lo(r.z); bq[5] = bf_hi(r.z); bq[6] = bf_lo(r.w); bq[7] = bf_hi(r.w); }
#pragma unroll
            for (int i = 0; i < 8; ++i) { const f32x2 cs = rope[pp * 8 + i]; const float x1 = a[i] * inv * kn[i], x2 = bq[i] * inv * kn[8 + i]; a[i] = x1 * cs[0] - x2 * cs[1]; bq[i] = x2 * cs[0] + x1 * cs[1]; }
            u32x4 r; r.x = pk_bf16(a[0], a[1]); r.y = pk_bf16(a[2], a[3]); r.z = pk_bf16(a[4], a[5]); r.w = pk_bf16(a[6], a[7]); dst[0] = r;
            r.x = pk_bf16(bq[0], bq[1]); r.y = pk_bf16(bq[2], bq[3]); r.z = pk_bf16(bq[4], bq[5]); r.w = pk_bf16(bq[6], bq[7]); dst[1] = r;
        }
#pragma unroll
        for (int i = 2; i < 8; ++i) { const u32x4 r = raw[i]; const float* kg = kn + 8 * i; u32x4 o;
            o.x = pk_bf16(bf_lo(r.x) * inv * kg[0], bf_hi(r.x) * inv * kg[1]); o.y = pk_bf16(bf_lo(r.y) * inv * kg[2], bf_hi(r.y) * inv * kg[3]);
            o.z = pk_bf16(bf_lo(r.z) * inv * kg[4], bf_hi(r.z) * inv * kg[5]); o.w = pk_bf16(bf_lo(r.w) * inv * kg[6], bf_hi(r.w) * inv * kg[7]); dst[i] = o; }
    } else {
        const int key = tid - 256, pos = pos0 + key;
        const u32x4* src = (const u32x4*)(Z + (rowbase + (pos >= 0 ? pos : 0)) * ZP + ZC_VA + kvh * 64);
#pragma unroll
        for (int i = 0; i < 8; ++i) {
            u32x4 r = src[i]; if (pos < 0) r = (u32x4){0u, 0u, 0u, 0u};
            VT[(8 * i + 0) * 264 + key] = (bf16_t)(r.x & 0xffffu); VT[(8 * i + 1) * 264 + key] = (bf16_t)(r.x >> 16);
            VT[(8 * i + 2) * 264 + key] = (bf16_t)(r.y & 0xffffu); VT[(8 * i + 3) * 264 + key] = (bf16_t)(r.y >> 16);
            VT[(8 * i + 4) * 264 + key] = (bf16_t)(r.z & 0xffffu); VT[(8 * i + 5) * 264 + key] = (bf16_t)(r.z >> 16);
            VT[(8 * i + 6) * 264 + key] = (bf16_t)(r.w & 0xffffu); VT[(8 * i + 7) * 264 + key] = (bf16_t)(r.w >> 16);
        }
    }
    __syncthreads();
#pragma unroll 2
    for (int hh = 0; hh < 4; ++hh) {
        const int head = kvh * 4 + hh;
        bf16_t* qptr = Z + grow * ZP + ZC_QA + head * 64;
        float xq[2][8];
        const u32x4 qr0 = qn0, qr1 = qn1;
        if (hh < 3) { qn0 = *(const u32x4*)(qptr + 64 + 8 * g); qn1 = *(const u32x4*)(qptr + 64 + 32 + 8 * g); }
#pragma unroll
        for (int kk = 0; kk < 2; ++kk) { const u32x4 r = kk == 0 ? qr0 : qr1;
            xq[kk][0] = bf_lo(r.x); xq[kk][1] = bf_hi(r.x); xq[kk][2] = bf_lo(r.y); xq[kk][3] = bf_hi(r.y); xq[kk][4] = bf_lo(r.z); xq[kk][5] = bf_hi(r.z); xq[kk][6] = bf_lo(r.w); xq[kk][7] = bf_hi(r.w); }
        float ss = 0.f;
#pragma unroll
        for (int kk = 0; kk < 2; ++kk)
#pragma unroll
            for (int i = 0; i < 8; ++i) ss += xq[kk][i] * xq[kk][i];
        ss = rowsum4(ss);
        const float inv = rsqrtf(ss * (1.0f / 64.0f) + EPS);
#pragma unroll
        for (int kk = 0; kk < 2; ++kk)
#pragma unroll
            for (int i = 0; i < 8; ++i) xq[kk][i] = xq[kk][i] * inv * qn[32 * kk + 8 * g + i];
#pragma unroll
        for (int i = 0; i < 8; ++i) {
            const auto pr = __builtin_amdgcn_permlane16_swap(__float_as_uint(xq[0][i]), __float_as_uint(xq[0][i]), false, false);
            const float other = __uint_as_float((g & 1) ? pr[0] : pr[1]); const f32x2 cs = rope[qpos * 8 + i];
            if (g == 0) xq[0][i] = xq[0][i] * cs[0] - other * cs[1];
            else if (g == 1) xq[0][i] = xq[0][i] * cs[0] + other * cs[1];
        }
        bf16x8 qf[2];
#pragma unroll
        for (int kk = 0; kk < 2; ++kk) { u32x4 r; const float qsc = 0.125f * 1.4426950408889634f; r.x = pk_bf16(xq[kk][0] * qsc, xq[kk][1] * qsc); r.y = pk_bf16(xq[kk][2] * qsc, xq[kk][3] * qsc); r.z = pk_bf16(xq[kk][4] * qsc, xq[kk][5] * qsc); r.w = pk_bf16(xq[kk][6] * qsc, xq[kk][7] * qsc); qf[kk] = __builtin_bit_cast(bf16x8, r); }
        f32x4 sc[9];
#pragma unroll
        for (int t = 0; t < 9; ++t) {
            const int kt = w + t;
            const bf16x8 a0 = *(const bf16x8*)(Ks + (16 * kt + l15) * 72 + 8 * g), a1 = *(const bf16x8*)(Ks + (16 * kt + l15) * 72 + 32 + 8 * g);
            f32x4 c = {0.f, 0.f, 0.f, 0.f};
            c = __builtin_amdgcn_mfma_f32_16x16x32_bf16(a0, qf[0], c, 0, 0, 0);
            c = __builtin_amdgcn_mfma_f32_16x16x32_bf16(a1, qf[1], c, 0, 0, 0);
            sc[t] = c;
        }
        const float sink = sinks[head] * 1.4426950408889634f;
        float mx = sink;
        const int dlt = 4 * g - l15;
#pragma unroll
        for (int t = 0; t < 9; ++t) {
            const bool tile_ok = (n > 0) || (w + t >= 8);
#pragma unroll
            for (int j = 0; j < 4; ++j) {
                bool valid = tile_ok;
                if (t == 0) valid = valid && (dlt + j > 0);
                if (t == 8) valid = (dlt + j <= 0);
                sc[t][j] = valid ? sc[t][j] : -INFINITY;
                mx = fmaxf(mx, sc[t][j]);
            }
        }
        mx = rowmax4(mx);
        float sum = 0.f;
#pragma unroll
        for (int t = 0; t < 9; ++t)
#pragma unroll
            for (int j = 0; j < 4; ++j) { const float p = __builtin_amdgcn_exp2f(sc[t][j] - mx); sc[t][j] = p; sum += p; }
        sum = rowsum4(sum);
        const float rden = __builtin_amdgcn_rcpf(sum + __builtin_amdgcn_exp2f(sink - mx));
        f32x4 o[4];
#pragma unroll
        for (int dt = 0; dt < 4; ++dt) o[dt] = (f32x4){0.f, 0.f, 0.f, 0.f};
#pragma unroll
        for (int pp = 0; pp < 5; ++pp) {
            const int t0 = 2 * pp, t1 = (2 * pp + 1 < 9) ? 2 * pp + 1 : 2 * pp;
            u32x4 pb; pb.x = pk_bf16(sc[t0][0] * rden, sc[t0][1] * rden); pb.y = pk_bf16(sc[t0][2] * rden, sc[t0][3] * rden);
            if (2 * pp + 1 < 9) { pb.z = pk_bf16(sc[t1][0] * rden, sc[t1][1] * rden); pb.w = pk_bf16(sc[t1][2] * rden, sc[t1][3] * rden); } else { pb.z = 0u; pb.w = 0u; }
            const bf16x8 bfrag = __builtin_bit_cast(bf16x8, pb);
            const int k0 = 16 * (w + t0) + 4 * g, k1 = 16 * (w + t1) + 4 * g;
#pragma unroll
            for (int dt = 0; dt < 4; ++dt) {
                const bf16_t* vr = VT + (16 * dt + l15) * 264;
                const u32x2 lo = *(const u32x2*)(vr + k0), hi = *(const u32x2*)(vr + k1);
                const u32x4 av = {lo.x, lo.y, hi.x, hi.y};
                o[dt] = __builtin_amdgcn_mfma_f32_16x16x32_bf16(__builtin_bit_cast(bf16x8, av), bfrag, o[dt], 0, 0, 0);
            }
        }
#pragma unroll
        for (int dt = 0; dt < 4; ++dt) { u32x2 r; r.x = pk_bf16(o[dt][0], o[dt][1]); r.y = pk_bf16(o[dt][2], o[dt][3]); *(u32x2*)(qptr + 16 * dt + 4 * g) = r; }
    }
    __syncthreads();
}

__device__ __forceinline__ float logsigmoidf_(float x) { return fminf(x, 0.f) - __logf(1.0f + __expf(-fabsf(x))); }

__device__ __forceinline__ void m1_item4(unsigned char* lds, const bf16_t* Z, const float* gbias, bf16_t* dC, float* dn, float* gArr, float* mlArr, int item4) {
    int tid_ = threadIdx.x; asm volatile("" : "+v"(tid_));
    const int tid = tid_, lane = tid & 63, w = __builtin_amdgcn_readfirstlane(tid >> 6), l15 = lane & 15, g = lane >> 4;
    const int c = item4 & 63, b = item4 >> 6;
    const size_t rowbase = (size_t)b * SEQ + c * 64;
    constexpr int HB = 28160;
    const int t = tid & 63, pc = tid >> 6;
    const bf16_t* zr = Z + (rowbase + t) * ZP;
    u32x4 rk[4], rv0[4], rv1[4];
#pragma unroll
    for (int j = 0; j < 4; ++j) {
        rk[j] = *(const u32x4*)(zr + ZC_KM + j * 64 + 8 * pc);
        rv0[j] = *(const u32x4*)(zr + ZC_VM + j * 128 + 8 * pc);
        rv1[j] = *(const u32x4*)(zr + ZC_VM + j * 128 + 8 * (pc + 8));
    }
    if (w < 4) {
        const int h = w;
        const u32x4 gq = *(const u32x4*)(zr + ZC_IF);
        const unsigned iw = (h < 2) ? gq.x : gq.y, fw = (h < 2) ? gq.z : gq.w;
        const float ipre = ((h & 1) ? bf_hi(iw) : bf_lo(iw)) + gbias[h], fpre = ((h & 1) ? bf_hi(fw) : bf_lo(fw)) + gbias[4 + h];
        float v = logsigmoidf_(fpre);
#pragma unroll
        for (int o = 1; o < 64; o <<= 1) { const float u = __shfl_up(v, o); if (lane >= o) v += u; }
        const float gt = __shfl(v, 63);
        const float wend = gt - v + ipre;
        const float ml = wave_max(wend);
        ((float*)(lds + h * HB))[lane] = __expf(wend - ml);
        if (lane == 0) { gArr[item4 * 4 + h] = gt; mlArr[item4 * 4 + h] = ml; }
    }
    __syncthreads();
#pragma unroll
    for (int j = 0; j < 4; ++j) {
        const float e = ((const float*)(lds + j * HB))[t];
        bf16_t* KT = (bf16_t*)(lds + j * HB + 256); bf16_t* VT = KT + 64 * 72;
        const u32x4 r = rk[j];
        const unsigned p0 = pk_bf16(bf_lo(r.x) * e, bf_hi(r.x) * e), p1 = pk_bf16(bf_lo(r.y) * e, bf_hi(r.y) * e), p2 = pk_bf16(bf_lo(r.z) * e, bf_hi(r.z) * e), p3 = pk_bf16(bf_lo(r.w) * e, bf_hi(r.w) * e);
        bf16_t* d = KT + (8 * pc) * 72 + t;
        d[0] = (bf16_t)(p0 & 0xffffu); d[72] = (bf16_t)(p0 >> 16); d[144] = (bf16_t)(p1 & 0xffffu); d[216] = (bf16_t)(p1 >> 16);
        d[288] = (bf16_t)(p2 & 0xffffu); d[360] = (bf16_t)(p2 >> 16); d[432] = (bf16_t)(p3 & 0xffffu); d[504] = (bf16_t)(p3 >> 16);
#pragma unroll
        for (int rep = 0; rep < 2; ++rep) {
            const int pv = pc + 8 * rep;
            const u32x4 q = rep == 0 ? rv0[j] : rv1[j];
            bf16_t* dv = VT + (8 * pv) * 72 + t;
            dv[0] = (bf16_t)(q.x & 0xffffu); dv[72] = (bf16_t)(q.x >> 16); dv[144] = (bf16_t)(q.y & 0xffffu); dv[216] = (bf16_t)(q.y >> 16);
            dv[288] = (bf16_t)(q.z & 0xffffu); dv[360] = (bf16_t)(q.z >> 16); dv[432] = (bf16_t)(q.w & 0xffffu); dv[504] = (bf16_t)(q.w >> 16);
        }
    }
    __syncthreads();
#pragma unroll
    for (int j = 0; j < 4; ++j) {
        const bf16_t* KT = (const bf16_t*)(lds + j * HB + 256); const bf16_t* VT = KT + 64 * 72;
        const bf16_t* ar = VT + (16 * w + l15) * 72 + 8 * g;
        const bf16x8 a0 = *(const bf16x8*)(ar), a1 = *(const bf16x8*)(ar + 32);
        bf16_t* dst = dC + (size_t)(item4 * 4 + j) * 8192 + (16 * w + l15) * 64 + 4 * g;
#pragma unroll
        for (int kt = 0; kt < 4; ++kt) {
            const bf16_t* br = KT + (16 * kt + l15) * 72 + 8 * g;
            const bf16x8 b0 = *(const bf16x8*)(br), b1 = *(const bf16x8*)(br + 32);
            f32x4 acc = {0.f, 0.f, 0.f, 0.f};
            acc = __builtin_amdgcn_mfma_f32_16x16x32_bf16(b0, a0, acc, 0, 0, 0);
            acc = __builtin_amdgcn_mfma_f32_16x16x32_bf16(b1, a1, acc, 0, 0, 0);
            u32x2 o; o.x = pk_bf16(acc[0], acc[1]); o.y = pk_bf16(acc[2], acc[3]);
            *(u32x2*)(dst + 16 * kt) = o;
        }
    }
    if (tid < 256) {
        const int j = tid >> 6, k = tid & 63;
        float s = 0.f; const bf16_t* kr = (const bf16_t*)(lds + j * HB + 256) + k * 72;
#pragma unroll 8
        for (int tt = 0; tt < 64; ++tt) s += bf2f(kr[tt]);
        dn[(size_t)(item4 * 4 + j) * 64 + k] = s;
    }
    __syncthreads();
}

__device__ __forceinline__ float rdlane(float v, int l) { return __int_as_float(__builtin_amdgcn_readlane(__float_as_int(v), l)); }
__device__ __forceinline__ void scan_item(unsigned char* lds, unsigned* dC, float* dn, const float* gArr, const float* mlArr, float* mp, int item) {
    int tid_ = threadIdx.x; asm volatile("" : "+v"(tid_));
    const int tid = tid_, lane = tid & 63;
    const int bh = item >> 3, sl = item & 7, b = bh >> 2, h = bh & 3;
    const int base_idx = (b * NCH) * 4 + h;
    float* sa_ = (float*)lds; float* ss_ = sa_ + 64;
    if (tid < 64) {
        const float gv = gArr[base_idx + 4 * lane], mlv = mlArr[base_idx + 4 * lane];
        float av = 0.f, sv = 0.f, mv = 0.f, m = 0.f;
#pragma unroll
        for (int c = 0; c < 64; ++c) {
            const float gc = rdlane(gv, c), ml = rdlane(mlv, c);
            const float mnew = fmaxf(gc + m, ml);
            const float a = __expf(gc + m - mnew), s_ = __expf(ml - mnew);
            if (lane == c) { av = a; sv = s_; mv = m; }
            m = mnew;
        }
        sa_[lane] = av; ss_[lane] = sv;
        if (sl == 0) mp[base_idx + 4 * lane] = mv;
    }
    __syncthreads();
    const bool do_n = (sl == 0) && (tid < 64);
    unsigned* p = dC + (size_t)base_idx * 4096 + sl * 512 + tid;
    float* pn = dn + (size_t)base_idx * 64 + (tid & 63);
    float C0 = 0.f, C1 = 0.f, nst = 0.f;
    unsigned cv[8]; float cnv[8];
#pragma unroll
    for (int i = 0; i < 8; ++i) { cv[i] = p[(size_t)i * 16384]; cnv[i] = do_n ? pn[i * 256] : 0.f; }
#pragma unroll
    for (int cg = 0; cg < 8; ++cg) {
        unsigned nv[8]; float nnv[8];
        if (cg < 7) {
#pragma unroll
            for (int i = 0; i < 8; ++i) { const int c = cg * 8 + 8 + i; nv[i] = p[(size_t)c * 16384]; nnv[i] = do_n ? pn[c * 256] : 0.f; }
        }
        asm volatile("" ::: "memory");
#pragma unroll
        for (int i = 0; i < 8; ++i) {
            const int c = cg * 8 + i;
            const float a = sa_[c], s_ = ss_[c];
            p[(size_t)c * 16384] = pk_bf16(C0, C1); if (do_n) pn[c * 256] = nst;
            C0 = a * C0 + s_ * bf_lo(cv[i]); C1 = a * C1 + s_ * bf_hi(cv[i]); nst = a * nst + s_ * cnv[i];
        }
        if (cg < 7) {
#pragma unroll
            for (int i = 0; i < 8; ++i) { cv[i] = nv[i]; cnv[i] = nnv[i]; }
        }
    }
    __syncthreads();
}

__device__ __forceinline__ void m3_item(unsigned char* lds, bf16_t* Z, const float* gbias, const float* hn, const bf16_t* Cp, const float* np, const float* mp, int item) {
    int tid_ = threadIdx.x; asm volatile("" : "+v"(tid_));
    const int tid = tid_, lane = tid & 63, w = __builtin_amdgcn_readfirstlane(tid >> 6), l15 = lane & 15, g = lane >> 4;
    const int hp = item & 1, c = (item >> 1) & 63, b = item >> 7;
    const int gr = w >> 2, tt = w & 3, h = 2 * hp + gr, tg = tid & 255;
    const int idx = (b * NCH + c) * 4 + h;
    const size_t rowbase = (size_t)b * SEQ + c * 64;
    unsigned char* gl = lds + gr * 20480;
    bf16_t* VT = (bf16_t*)gl;
    float* sb = (float*)(gl + 18432);
    float* su = sb + 64;
    float* sm = sb + 128;
    float* sa = sb + 192;
    const int t = 16 * tt + l15;
    bf16_t* zrow = Z + (rowbase + t) * ZP;
    u32x4 vq[4];
#pragma unroll
    for (int rep = 0; rep < 4; ++rep) vq[rep] = *(const u32x4*)(Z + (rowbase + (tg & 63)) * ZP + ZC_VM + h * 128 + 8 * ((tg >> 6) + 4 * rep));
    unsigned ifp = 0u; float mprev = 0.f;
    if (tt == 0) { const bf16_t* zr = Z + (rowbase + lane) * ZP + ZC_IF; ifp = (unsigned)zr[h] | ((unsigned)zr[4 + h] << 16); mprev = mp[idx]; }
    u32x4 qraw[2];
#pragma unroll
    for (int kk = 0; kk < 2; ++kk) qraw[kk] = *(const u32x4*)(zrow + ZC_QM + h * 64 + 8 * g + 32 * kk);
    u32x4 kraw[4][2];
#pragma unroll
    for (int st = 0; st < 4; ++st)
#pragma unroll
        for (int kk = 0; kk < 2; ++kk) {
            kraw[st][kk] = (u32x4){0u, 0u, 0u, 0u};
            if (st <= tt) kraw[st][kk] = *(const u32x4*)(Z + (rowbase + 16 * st + l15) * ZP + ZC_KM + h * 64 + 8 * g + 32 * kk);
        }
    u32x2 og[8];
#pragma unroll
    for (int vt = 0; vt < 8; ++vt) og[vt] = *(const u32x2*)(zrow + ZC_OM + h * 128 + 16 * vt + 4 * g);
    const bf16_t* cb = Cp + (size_t)idx * 8192 + l15 * 64 + 8 * g;
    u32x4 cpre[8][2];
#pragma unroll
    for (int vt = 0; vt < 8; ++vt)
#pragma unroll
        for (int kk = 0; kk < 2; ++kk) cpre[vt][kk] = *(const u32x4*)(cb + vt * 1024 + 32 * kk);
    f32x4 npre[2][2];
#pragma unroll
    for (int kk = 0; kk < 2; ++kk) { npre[kk][0] = (f32x4){0.f, 0.f, 0.f, 0.f}; npre[kk][1] = npre[kk][0];
        if (l15 == 0) { npre[kk][0] = *(const f32x4*)(np + (size_t)idx * 64 + 32 * kk + 8 * g); npre[kk][1] = *(const f32x4*)(np + (size_t)idx * 64 + 32 * kk + 8 * g + 4); } }
    if (tt == 0) {
        const float ipre = bf_lo(ifp) + gbias[h], fpre = bf_hi(ifp) + gbias[4 + h];
        float v = logsigmoidf_(fpre);
#pragma unroll
        for (int o = 1; o < 64; o <<= 1) { const float u = __shfl_up(v, o); if (lane >= o) v += u; }
        const float u = ipre - v;
        float pm = u;
#pragma unroll
        for (int o = 1; o < 64; o <<= 1) { const float q = __shfl_up(pm, o); if (lane >= o) pm = fmaxf(pm, q); }
        const float mt = v + fmaxf(mprev, pm);
        sb[lane] = v; su[lane] = u; sm[lane] = mt; sa[lane] = __expf(v + mprev - mt);
    }
    {
        const int ts = tg & 63;
#pragma unroll
        for (int rep = 0; rep < 4; ++rep) {
            const int pv = (tg >> 6) + 4 * rep;
            const u32x4 q = vq[rep];
            bf16_t* dv = VT + (8 * pv) * 72 + ts;
            dv[0] = (bf16_t)(q.x & 0xffffu); dv[72] = (bf16_t)(q.x >> 16); dv[144] = (bf16_t)(q.y & 0xffffu); dv[216] = (bf16_t)(q.y >> 16);
            dv[288] = (bf16_t)(q.z & 0xffffu); dv[360] = (bf16_t)(q.z >> 16); dv[432] = (bf16_t)(q.w & 0xffffu); dv[504] = (bf16_t)(q.w >> 16);
        }
    }
    __syncthreads();
    {
        const float bt = sb[t], mt = sm[t], at = sa[t];
        bf16x8 qf[2], qs[2];
#pragma unroll
        for (int kk = 0; kk < 2; ++kk) {
            const u32x4 r = qraw[kk]; qf[kk] = __builtin_bit_cast(bf16x8, r);
            const float sc = at * 0.125f; u32x4 s;
            s.x = pk_bf16(bf_lo(r.x) * sc, bf_hi(r.x) * sc); s.y = pk_bf16(bf_lo(r.y) * sc, bf_hi(r.y) * sc); s.z = pk_bf16(bf_lo(r.z) * sc, bf_hi(r.z) * sc); s.w = pk_bf16(bf_lo(r.w) * sc, bf_hi(r.w) * sc);
            qs[kk] = __builtin_bit_cast(bf16x8, s);
        }
        f32x4 wv[4]; float dsum = 0.f;
#pragma unroll
        for (int st = 0; st < 4; ++st) {
            wv[st] = (f32x4){0.f, 0.f, 0.f, 0.f};
            if (st <= tt) {
                f32x4 s = {0.f, 0.f, 0.f, 0.f};
                s = __builtin_amdgcn_mfma_f32_16x16x32_bf16(__builtin_bit_cast(bf16x8, kraw[st][0]), qf[0], s, 0, 0, 0);
                s = __builtin_amdgcn_mfma_f32_16x16x32_bf16(__builtin_bit_cast(bf16x8, kraw[st][1]), qf[1], s, 0, 0, 0);
#pragma unroll
                for (int j = 0; j < 4; ++j) {
                    const int sp = 16 * st + 4 * g + j;
                    const float wgt = (sp <= t) ? __expf(bt + su[sp] - mt) * s[j] * 0.125f : 0.f;
                    wv[st][j] = wgt; dsum += wgt;
                }
            }
        }
        dsum = rowsum4(dsum);
        f32x4 num[8];
#pragma unroll
        for (int vt = 0; vt < 8; ++vt) num[vt] = (f32x4){0.f, 0.f, 0.f, 0.f};
#pragma unroll
        for (int vt = 0; vt < 8; ++vt)
#pragma unroll
            for (int kk = 0; kk < 2; ++kk) num[vt] = __builtin_amdgcn_mfma_f32_16x16x32_bf16(__builtin_bit_cast(bf16x8, cpre[vt][kk]), qs[kk], num[vt], 0, 0, 0);
        f32x4 nacc = {0.f, 0.f, 0.f, 0.f};
#pragma unroll
        for (int kk = 0; kk < 2; ++kk) {
            const f32x4 c0 = npre[kk][0], c1 = npre[kk][1];
            u32x4 cv; cv.x = pk_bf16(c0[0], c0[1]); cv.y = pk_bf16(c0[2], c0[3]); cv.z = pk_bf16(c1[0], c1[1]); cv.w = pk_bf16(c1[2], c1[3]);
            nacc = __builtin_amdgcn_mfma_f32_16x16x32_bf16(__builtin_bit_cast(bf16x8, cv), qs[kk], nacc, 0, 0, 0);
        }
        const float nq = __shfl(nacc[0], l15);
#pragma unroll
        for (int k2 = 0; k2 < 2; ++k2) {
            if (2 * k2 <= tt) {
                u32x4 pb; pb.x = pk_bf16(wv[2 * k2][0], wv[2 * k2][1]); pb.y = pk_bf16(wv[2 * k2][2], wv[2 * k2][3]); pb.z = pk_bf16(wv[2 * k2 + 1][0], wv[2 * k2 + 1][1]); pb.w = pk_bf16(wv[2 * k2 + 1][2], wv[2 * k2 + 1][3]);
                const bf16x8 bfrag = __builtin_bit_cast(bf16x8, pb);
#pragma unroll
                for (int vt = 0; vt < 8; ++vt) {
                    const bf16_t* vr = VT + (16 * vt + l15) * 72 + 32 * k2 + 4 * g;
                    const u32x2 lo = *(const u32x2*)(vr), hi = *(const u32x2*)(vr + 16);
                    const u32x4 av = {lo.x, lo.y, hi.x, hi.y};
                    num[vt] = __builtin_amdgcn_mfma_f32_16x16x32_bf16(__builtin_bit_cast(bf16x8, av), bfrag, num[vt], 0, 0, 0);
                }
            }
        }
        const float den = dsum + nq;
        const float rd = __builtin_amdgcn_rcpf(fmaxf(fabsf(den), __expf(-mt)));
        float ss = 0.f;
#pragma unroll
        for (int vt = 0; vt < 8; ++vt) { num[vt] = num[vt] * rd; ss += (num[vt][0] * num[vt][0] + num[vt][1] * num[vt][1]) + (num[vt][2] * num[vt][2] + num[vt][3] * num[vt][3]); }
        ss = rowsum4(ss);
        const float rinv = rsqrtf(ss * (1.0f / 128.0f) + EPS);
#pragma unroll
        for (int vt = 0; vt < 8; ++vt) {
            const int v0 = h * 128 + 16 * vt + 4 * g;
            const f32x4 gn = *(const f32x4*)(hn + v0);
            const u32x2 o2 = og[vt];
            u32x2 r;
            r.x = pk_bf16(num[vt][0] * rinv * gn[0] * sigmoidf_(bf_lo(o2.x)), num[vt][1] * rinv * gn[1] * sigmoidf_(bf_hi(o2.x)));
            r.y = pk_bf16(num[vt][2] * rinv * gn[2] * sigmoidf_(bf_lo(o2.y)), num[vt][3] * rinv * gn[3] * sigmoidf_(bf_hi(o2.y)));
            *(u32x2*)(zrow + ZC_VM + v0) = r;
        }
    }
    __syncthreads();
}

#define XB_TMO      128
#define XB_XCNT(j)  (256  + 64 * (j))
#define XB_XSUB(j)  (1280 + 64 * (j))
#define XB_XGEN(j)  (2304 + 64 * (j))
#define XB_TOP      3328
#define XB_TOPGEN   3392
#define XCD_BAR_WORDS 3456
#define XB_SPIN_CAP (1u << 18)
__device__ __forceinline__ unsigned xb_ld(unsigned* p)              { return __hip_atomic_load(p, __ATOMIC_RELAXED, __HIP_MEMORY_SCOPE_AGENT); }
__device__ __forceinline__ unsigned xb_add(unsigned* p, unsigned v) { return __hip_atomic_fetch_add(p, v, __ATOMIC_RELAXED, __HIP_MEMORY_SCOPE_AGENT); }
__device__ __forceinline__ unsigned xb_xcc_id() { return (unsigned)__builtin_amdgcn_s_getreg((3 << 11) | 20) & 0xFu; }
#define XB_SPIN(cond, bar) do { unsigned _sp = 0; while (cond) { __builtin_amdgcn_s_sleep(1); \
    if ((++_sp & 255u) == 0u) { if (xb_ld(&(bar)[XB_TMO])) break; if (_sp > XB_SPIN_CAP) { atomicAdd(&(bar)[XB_TMO], 1u); break; } } } } while (0)
struct XcdBarrier { unsigned* bar; unsigned x; volatile LAS unsigned* st; };
__device__ __forceinline__ XcdBarrier xcd_barrier_post(unsigned* bar, volatile LAS unsigned* st) {
    XcdBarrier b; b.bar = bar; b.x = xb_xcc_id(); b.st = st;
    if (threadIdx.x == 0) (void)xb_add(&bar[XB_XCNT(b.x)], 1u);
    return b;
}
__device__ __forceinline__ void xcd_barrier_complete(unsigned* bar, unsigned x, unsigned& nloc, unsigned& nx) {
    const unsigned G = gridDim.x * gridDim.y * gridDim.z;
    unsigned sum, cnt, mine, sp = 0u;
    for (;;) {
        sum = 0u; cnt = 0u; mine = 0u;
#pragma unroll
        for (unsigned j = 0; j < 16; ++j) { const unsigned c = xb_ld(&bar[XB_XCNT(j)]); sum += c; cnt += (c > 0u) ? 1u : 0u; mine = (j == x) ? c : mine; }
        if (sum == G) break;
        __builtin_amdgcn_s_sleep(1);
        if ((++sp & 255u) == 0u) { if (xb_ld(&bar[XB_TMO])) break; if (sp > XB_SPIN_CAP) { atomicAdd(&bar[XB_TMO], 1u); break; } }
    }
    nloc = mine > 0u ? mine : 1u; nx = cnt > 0u ? cnt : 1u;
}
__device__ __forceinline__ void xcd_barrier(unsigned* bar, unsigned x, volatile LAS unsigned* st) {
    asm volatile("s_waitcnt vmcnt(0)" ::: "memory");
    __syncthreads();
    if (threadIdx.x == 0) {
        __builtin_amdgcn_s_waitcnt(0);
        unsigned nloc = st[0], nx = st[1];
        if (nloc == 0u) { xcd_barrier_complete(bar, x, nloc, nx); st[0] = nloc; st[1] = nx; }
        const unsigned old = xb_add(&bar[XB_XSUB(x)], 1u);
        const unsigned gen = old / nloc;
        if (old + 1u == (gen + 1u) * nloc) {
            __builtin_amdgcn_fence(__ATOMIC_RELEASE, "agent");
            asm volatile("s_waitcnt vmcnt(0)" ::: "memory");
            const unsigned og = xb_add(&bar[XB_TOP], 1u);
            const unsigned tg = og / nx;
            if (og + 1u == (tg + 1u) * nx) xb_add(&bar[XB_TOPGEN], 1u);
            else XB_SPIN(xb_ld(&bar[XB_TOPGEN]) == tg, bar);
            __builtin_amdgcn_fence(__ATOMIC_ACQUIRE, "agent");
            xb_add(&bar[XB_XGEN(x)], 1u);
            asm volatile("s_waitcnt vmcnt(0)" ::: "memory");
        } else {
            XB_SPIN(xb_ld(&bar[XB_XGEN(x)]) == gen, bar);
            __builtin_amdgcn_fence(__ATOMIC_ACQUIRE, "agent");
            asm volatile("s_waitcnt vmcnt(0)" ::: "memory");
        }
    }
    __syncthreads();
}

constexpr int PH_PER_LAYER = 9, N_PHASES = 1 + DEPTH * PH_PER_LAYER;

__global__ void __launch_bounds__(512, 2) fwd_kernel(Args Punused) {
    extern __shared__ __attribute__((aligned(16))) unsigned char lds_raw[];
    cg::grid_group grid = cg::this_grid();
    LAS unsigned char* ldsl = (LAS unsigned char*)lds_raw;
#define KP_DECL KArgs kp = (KArgs)__builtin_amdgcn_kernarg_segment_ptr(); asm volatile("" : "+s"(kp))
#define BST ((volatile LAS unsigned*)(ldsl + 131072))
    if (threadIdx.x < 4) BST[threadIdx.x] = 0u;
    __syncthreads();
#if MK_PER_PHASE_LAUNCH
    int lo, hi;
    { KP_DECL; lo = kp->ph_lo; hi = kp->ph_hi; }
#else
    constexpr int lo = 0, hi = N_PHASES;
    { KP_DECL; (void)xcd_barrier_post((unsigned*)(gptr(kp->ws) + WS_BAR), BST); }
#endif
#ifndef ONLY
#define ONLY -1
#endif
#define EN(n) (ONLY < 0 || ONLY == (n))
#define IN(k) (lo <= (k) && (k) < hi)
#define SYNC(k) do { if (IN((k) + 1)) { KP_DECL; xcd_barrier((unsigned*)(gptr(kp->ws) + WS_BAR), xb_xcc_id(), BST); } } while (0)
#define SYNC_CG(k) do { if (IN((k) + 1)) grid.sync(); } while (0)

    if (EN(0) && IN(0)) { KP_DECL; prologue(kp, lds_raw);
#if MK_PER_PHASE_LAUNCH
        SYNC_CG(0);
#else
        if (kp->ph_lo < 0) grid.sync();
        SYNC(0);
#endif
    }

#pragma unroll 1
    for (int l = 0; l < DEPTH; ++l) {
        const int p0 = 1 + l * PH_PER_LAYER;
        if (EN(1) && IN(p0 + 0)) {
            KP_DECL; unsigned char* ws = gptr(kp->ws); unsigned char* wl = ws + WS_W + (size_t)l * WL_SIZE;
            pg8::Gemm g{(const bf16_t*)(ws + WS_XB), (const bf16_t*)(wl + WL_IN), MROWS, ZP, DM, DM}; pg8::StaticOrder S; S.init(MROWS, ZP, (int)gridDim.x, (int)blockIdx.x);
            pg8::inv_prepass((LAS float*)(ldsl + pg8::LINV_OFF), (const float*)(ws + WS_RS), S);
            pg8::EpiScale<0> E{(bf16_t*)(ws + WS_Z), ZP, (const LAS float*)(ldsl + pg8::LINV_OFF), 17, 0};
            pg8::gemm_phase(ldsl, g, S, E);
            SYNC(p0 + 0);
        }
        if (EN(2) && IN(p0 + 1)) {
            KP_DECL; unsigned char* ws = gptr(kp->ws); const int G = gridDim.x;
            bf16_t* Z = (bf16_t*)(ws + WS_Z);
            for (int it = blockIdx.x; it < 512; it += G) {
                int item = it;
                if (G == 256) { const int c = it & 255, p = (c & 7) + 8 * (it >> 8); item = ((p >> 1) << 6) | ((c >> 3) << 1) | (p & 1); }
                attn_item(lds_raw, Z, (const f32x2*)(ws + WS_ROPE), gptr(kp->qn) + l * 64, gptr(kp->kn) + l * 64, gptr(kp->sinks) + l * 8, item);
            }
            for (int it = blockIdx.x; it < BATCH * NCH; it += G) m1_item4(lds_raw, Z, gptr(kp->gbias) + l * 8, (bf16_t*)(ws + WS_DC), (float*)(ws + WS_DN), (float*)(ws + WS_G), (float*)(ws + WS_ML), it);
            SYNC(p0 + 1);
        }
        if (EN(3) && IN(p0 + 2)) {
            KP_DECL; unsigned char* ws = gptr(kp->ws); const int G = gridDim.x;
            for (int it = blockIdx.x; it < 256; it += G) scan_item(lds_raw, (unsigned*)(ws + WS_DC), (float*)(ws + WS_DN), (const float*)(ws + WS_G), (const float*)(ws + WS_ML), (float*)(ws + WS_MP), it);
            SYNC(p0 + 2);
        }
        if (EN(4) && IN(p0 + 3)) {
            KP_DECL; unsigned char* ws = gptr(kp->ws); const int G = gridDim.x;
            for (int it = blockIdx.x; it < BATCH * NCH * 2; it += G) m3_item(lds_raw, (bf16_t*)(ws + WS_Z), gptr(kp->gbias) + l * 8, gptr(kp->hn) + l * 512, (const bf16_t*)(ws + WS_DC), (const float*)(ws + WS_DN), (const float*)(ws + WS_MP), it);
            SYNC(p0 + 3);
        }
        if (EN(5) && IN(p0 + 4)) {
            KP_DECL; unsigned char* ws = gptr(kp->ws); unsigned char* wl = ws + WS_W + (size_t)l * WL_SIZE; bf16_t* Z = (bf16_t*)(ws + WS_Z);
            pg8::Gemm g{Z + ZC_QA, (const bf16_t*)(wl + WL_AB), MROWS, DM, 512, ZP}; pg8::StaticOrder S; S.init(MROWS, DM, (int)gridDim.x, (int)blockIdx.x);
            pg8::EpiGate<0> E{(bf16_t*)(ws + WS_DC), Z, ZC_GA};
            pg8::gemm_phase(ldsl, g, S, E);
            __syncthreads();
        }
        if (EN(6) && IN(p0 + 5)) {
            KP_DECL; unsigned char* ws = gptr(kp->ws); unsigned char* wl = ws + WS_W + (size_t)l * WL_SIZE; bf16_t* Z = (bf16_t*)(ws + WS_Z);
            pg8::Gemm g{Z + ZC_VM, (const bf16_t*)(wl + WL_MB), MROWS, DM, 512, ZP}; pg8::StaticOrder S; S.init(MROWS, DM, (int)gridDim.x, (int)blockIdx.x);
            pg8::EpiGate<1> E{(bf16_t*)(ws + WS_DC), Z, ZC_GM};
            pg8::gemm_phase(ldsl, g, S, E);
            SYNC(p0 + 5);
        }
        if (EN(7) && IN(p0 + 6)) {
            KP_DECL; unsigned char* ws = gptr(kp->ws); unsigned char* wl = ws + WS_W + (size_t)l * WL_SIZE;
            pg8::Gemm g{(const bf16_t*)(ws + WS_DC), (const bf16_t*)(wl + WL_OUT), MROWS, DM, DM, DM}; pg8::StaticOrder S; S.init(MROWS, DM, (int)gridDim.x, (int)blockIdx.x);
            pg8::EpiRes<0> E{gptr(kp->out), (bf16_t*)(ws + WS_XB), (float*)(ws + WS_RS)};
            pg8::gemm_phase(ldsl, g, S, E);
            SYNC(p0 + 6);
        }
        if (EN(8) && IN(p0 + 7)) {
            KP_DECL; unsigned char* ws = gptr(kp->ws); unsigned char* wl = ws + WS_W + (size_t)l * WL_SIZE;
            pg8::Gemm g{(const bf16_t*)(ws + WS_XB), (const bf16_t*)(wl + WL_1), MROWS, DFF, DM, DM}; pg8::StaticOrder S; S.init(MROWS, DFF, (int)gridDim.x, (int)blockIdx.x);
            pg8::inv_prepass((LAS float*)(ldsl + pg8::LINV_OFF), (const float*)(ws + WS_RS), S);
            pg8::EpiScale<1> E{(bf16_t*)(ws + WS_Z), DFF, (const LAS float*)(ldsl + pg8::LINV_OFF), -1, 1};
            pg8::gemm_phase(ldsl, g, S, E);
            SYNC(p0 + 7);
        }
        if (EN(9) && IN(p0 + 8)) {
            KP_DECL; unsigned char* ws = gptr(kp->ws); unsigned char* wl = ws + WS_W + (size_t)l * WL_SIZE;
            pg8::Gemm g{(const bf16_t*)(ws + WS_Z), (const bf16_t*)(wl + WL_2), MROWS, DM, DFF, 64, 1};     pg8::StaticOrder S; S.init(MROWS, DM, (int)gridDim.x, (int)blockIdx.x);
            if (l == DEPTH - 1) { pg8::EpiRes<1> E{gptr(kp->out), (bf16_t*)(ws + WS_XB), (float*)(ws + WS_RS)}; pg8::gemm_phase(ldsl, g, S, E); }
            else { pg8::EpiRes<0> E{gptr(kp->out), (bf16_t*)(ws + WS_XB), (float*)(ws + WS_RS)}; pg8::gemm_phase(ldsl, g, S, E); }
            SYNC(p0 + 8);
        }
    }
#undef IN
#undef SYNC
}

extern "C" void kernel_launch(void* const* d_in, const int* in_sizes, int n_in, void* d_out, int out_size, void* d_ws, size_t ws_size, hipStream_t stream) {
    static int grid = 0;
    if (grid == 0) {
        if (n_in != 14 || in_sizes[0] != MROWS * DM || out_size != MROWS * DM || ws_size < WS_END) {
            fprintf(stderr, "kernel_launch: unexpected shapes / workspace (n_in %d, in0 %d, out %d, ws %zu); nothing launched\n", n_in, n_in > 0 ? in_sizes[0] : -1, out_size, ws_size); grid = -1; return; }
        int dev = 0, cus = 0, per_cu = 0;
        hipGetDevice(&dev); hipDeviceGetAttribute(&cus, hipDeviceAttributeMultiprocessorCount, dev);
        if (hipFuncSetAttribute((const void*)fwd_kernel, hipFuncAttributeMaxDynamicSharedMemorySize, LDS_BYTES) != hipSuccess) { fprintf(stderr, "kernel_launch: hipFuncSetAttribute failed\n"); grid = -1; return; }
        if (hipOccupancyMaxActiveBlocksPerMultiprocessor(&per_cu, (const void*)fwd_kernel, 512, LDS_BYTES) != hipSuccess || per_cu < 1) { fprintf(stderr, "kernel_launch: occupancy query failed (%d)\n", per_cu); per_cu = 1; (void)hipGetLastError(); }
        grid = cus * (per_cu > 1 ? 1 : per_cu);
        if (grid <= 0) { grid = -1; return; }
    }
    if (grid < 0) return;
    Args a{};
    a.x = (const float*)d_in[0]; a.norm_mix = (const float*)d_in[1]; a.w_in = (const float*)d_in[2]; a.qn = (const float*)d_in[3]; a.kn = (const float*)d_in[4];
    a.sinks = (const float*)d_in[5]; a.gbias = (const float*)d_in[6]; a.hn = (const float*)d_in[7]; a.w_ab = (const float*)d_in[8]; a.w_mb = (const float*)d_in[9];
    a.w_out = (const float*)d_in[10]; a.norm_ffn = (const float*)d_in[11]; a.w1 = (const float*)d_in[12]; a.w2 = (const float*)d_in[13];
    a.out = (float*)d_out; a.ws = (unsigned char*)d_ws;
    for (int i = 0; i < 8; ++i) a.inv_freq[i] = (float)pow(500000.0, -(double)(2 * i) / 16.0);
#if MK_PER_PHASE_LAUNCH
    for (int p = 0; p < N_PHASES; ++p) {
        a.ph_lo = p; a.ph_hi = p + 1;
        hipLaunchKernelGGL(fwd_kernel, dim3(grid), dim3(512), LDS_BYTES, stream, a);
    }
#else
    a.ph_lo = 0; a.ph_hi = N_PHASES;
    if (hipMemsetAsync((char*)d_ws + WS_BAR, 0, 16384, stream) != hipSuccess) { fprintf(stderr, "kernel_launch: memset of barrier words failed\n"); return; }
    void* args[] = {&a};
    hipError_t e = hipLaunchCooperativeKernel((const void*)fwd_kernel, dim3(grid), dim3(512), args, LDS_BYTES, stream);
    if (e != hipSuccess) fprintf(stderr, "cooperative launch failed: %s (grid %d)\n", hipGetErrorString(e), grid);
#endif
}
```

```cpp
#include <hip/hip_runtime.h>
#include <hip/hip_cooperative_groups.h>
#include <cstdio>
#include <cstdint>
#include <cmath>
namespace cg = cooperative_groups;

#ifndef MK_PER_PHASE_LAUNCH
#define MK_PER_PHASE_LAUNCH 0
#endif

#define LAS __attribute__((address_space(3)))
typedef unsigned short bf16_t;
typedef short bf16x8 __attribute__((ext_vector_type(8)));
typedef float f32x4 __attribute__((ext_vector_type(4)));
typedef float f32x2 __attribute__((ext_vector_type(2)));
typedef unsigned u32x4 __attribute__((ext_vector_type(4)));
typedef unsigned u32x2 __attribute__((ext_vector_type(2)));

constexpr int DM = 1024, BATCH = 8, SEQ = 4096, MROWS = BATCH * SEQ, DFF = 4096, DEPTH = 2;
constexpr int ZP = 4608;
constexpr int ZC_QA = 0, ZC_KA = 512, ZC_VA = 640, ZC_QM = 768, ZC_KM = 1024, ZC_VM = 1280, ZC_OM = 1792, ZC_GA = 2304, ZC_GM = 3328, ZC_IF = 4352;
constexpr int DIN_SRC = 4360;
constexpr float EPS = 1e-6f;
constexpr int NCH = 64;
constexpr int NITEM_M = BATCH * NCH * 4;

constexpr size_t MiB = 1u << 20;
constexpr size_t WS_RS = 0;
constexpr size_t WS_ROPE = 2 * MiB;
constexpr size_t WS_DN = 3 * MiB;
constexpr size_t WS_G = 4 * MiB;
constexpr size_t WS_ML = 4 * MiB + 65536;
constexpr size_t WS_MP = 4 * MiB + 131072;
constexpr size_t WS_W = 8 * MiB;
constexpr size_t WL_IN = 0, WL_AB = 9 * MiB, WL_MB = 10 * MiB, WL_OUT = 11 * MiB, WL_1 = 13 * MiB, WL_2 = 21 * MiB, WL_SIZE = 29 * MiB;
constexpr size_t WS_XB = 66 * MiB;
constexpr size_t WS_Z = 130 * MiB;
constexpr size_t WS_DC = 418 * MiB;
constexpr size_t WS_END = 482 * MiB;

constexpr int LDS_BYTES = 131072 + 64 + 9 * 256 * 4;
constexpr size_t WS_BAR = 5 * MiB;

#define GAS __attribute__((address_space(1)))
template <class T> __device__ __forceinline__ T* gptr(T* p) { return (T*)(GAS T*)p; }
__device__ __forceinline__ unsigned pk_bf16(float lo, float hi) {
    typedef __bf16 b2 __attribute__((ext_vector_type(2)));
    f32x2 v = {lo, hi}; b2 r = __builtin_convertvector(v, b2); return __builtin_bit_cast(unsigned, r);
}
__device__ __forceinline__ float bf_lo(unsigned u) { return __uint_as_float(u << 16); }
__device__ __forceinline__ float bf_hi(unsigned u) { return __uint_as_float(u & 0xffff0000u); }
__device__ __forceinline__ float bf2f(bf16_t v) { return __uint_as_float(((unsigned)v) << 16); }
__device__ __forceinline__ float sigmoidf_(float x) { return __builtin_amdgcn_rcpf(1.0f + __expf(-x)); }
__device__ __forceinline__ float xsum16(float v) { const auto r = __builtin_amdgcn_permlane16_swap(__float_as_uint(v), __float_as_uint(v), false, false); return __uint_as_float(r[0]) + __uint_as_float(r[1]); }
__device__ __forceinline__ float xsum32(float v) { const auto r = __builtin_amdgcn_permlane32_swap(__float_as_uint(v), __float_as_uint(v), false, false); return __uint_as_float(r[0]) + __uint_as_float(r[1]); }
__device__ __forceinline__ float xmax16(float v) { const auto r = __builtin_amdgcn_permlane16_swap(__float_as_uint(v), __float_as_uint(v), false, false); return fmaxf(__uint_as_float(r[0]), __uint_as_float(r[1])); }
__device__ __forceinline__ float xmax32(float v) { const auto r = __builtin_amdgcn_permlane32_swap(__float_as_uint(v), __float_as_uint(v), false, false); return fmaxf(__uint_as_float(r[0]), __uint_as_float(r[1])); }
__device__ __forceinline__ float rowsum4(float v) { return xsum32(xsum16(v)); }
__device__ __forceinline__ float rowmax4(float v) { return xmax32(xmax16(v)); }
__device__ __forceinline__ float wave_sum(float v) {
#pragma unroll
    for (int o = 1; o < 64; o <<= 1) v += __shfl_xor(v, o);
    return v;
}
__device__ __forceinline__ float wave_max(float v) {
#pragma unroll
    for (int o = 1; o < 64; o <<= 1) v = fmaxf(v, __shfl_xor(v, o));
    return v;
}

#ifndef PG8_ALIGN
#define PG8_ALIGN 1
#endif
namespace pg8 {
constexpr int BM = 256, BK = 64, HALF = 128, HTB = HALF * BK * 2, NXCD = 8, WGM = 4;
__device__ __forceinline__ int lds_byte(int r, int c) { const int st = (r >> 4) * 2 + (c >> 5), rr = r & 15, cc = c & 31, ob = rr * 64 + cc * 2; return st * 1024 + (ob ^ (((ob >> 9) & 1) << 5)); }
__device__ __forceinline__ void stage_rc(int b, int& R, int& C) { const int st = b / 1024, sb = b % 1024, swz = sb ^ (((sb >> 9) & 1) << 5); R = (st >> 1) * 16 + swz / 64; C = (st & 1) * 32 + (swz % 64) / 2; }
__device__ __forceinline__ int perm32(int rho) { const int n = rho >> 4, i = rho & 15; return 8 * (i >> 2) + 4 * n + (i & 3); }

struct Unit { int pm, pn, idx; };
struct Gemm { const bf16_t* A; const bf16_t* Bt; int M, N, K, lda, atiled, btiled; };

struct StaticOrder {
    int nM, nN, nwg, G, c;
    __device__ void init(int M, int N, int G_, int c_) { nM = M / BM; nN = N / BM; nwg = nM * nN; G = G_; c = c_; }
    __device__ bool next(int i, Unit& u) const {
        const long L = (long)i * G + c; if (L >= nwg) return false;
        int wgid = (int)L; { const int q = nwg / NXCD, r = nwg % NXCD, xcd = wgid % NXCD, off = wgid / NXCD; wgid = (xcd < r ? xcd * (q + 1) : r * (q + 1) + (xcd - r) * q) + off; }
        const int nig = WGM * nN, gid = wgid / nig, fm = gid * WGM, gsz = (nM - fm) < WGM ? (nM - fm) : WGM;
        u.pm = fm + ((wgid % nig) % gsz); u.pn = (wgid % nig) / gsz; u.idx = i; return true;
    }
};

template <class Epi>
__device__ __forceinline__ void gemm_phase(LAS unsigned char* lds, const Gemm g, const StaticOrder& S, const Epi& E) {
    int tid_ = threadIdx.x; asm volatile("" : "+v"(tid_));
    const int tid = tid_, wid = __builtin_amdgcn_readfirstlane(tid >> 6), lane = tid & 63, wr = wid >> 2, wc = wid & 3, fr = lane & 15, fq = lane >> 4;
    const int K = g.K, nt = K / BK, lda = g.lda;
    unsigned voffA[2], voffB[2];
#pragma unroll
    for (int i = 0; i < 2; ++i) { int R, C; stage_rc(tid * 16 + i * 8192, R, C); const int Rb = Epi::PERM ? ((R & ~31) + perm32(R & 31)) : R;
        voffA[i] = (unsigned)(R * lda + C) * 2u; voffB[i] = (unsigned)(Rb * (g.btiled ? 64 : K) + C) * 2u; }
    const size_t kstep = (size_t)(BK * 2);
    const size_t kstepA = g.atiled ? (size_t)BM * BK * 2 : kstep;
    const size_t kstepB = g.btiled ? (size_t)BM * BK * 2 : kstep;
    const size_t hstepA = (size_t)HALF * lda * 2, hstepB = g.btiled ? (size_t)HALF * 64 * 2 : (size_t)HALF * K * 2;
    const size_t tstepA = g.atiled ? (size_t)BM * K * 2 : 2 * hstepA, tstepB = (size_t)BM * K * 2;
    const unsigned ldsw = (unsigned)wid * 1024u;
    const int aoff = lds_byte(wr * 64 + fr, fq * 8), boff = lds_byte(wc * 32 + fr, fq * 8);
#define PG8_SA(b, h) (((b) * 2 + (h)) * HTB)
#define PG8_SB(b, h) ((4 + (b) * 2 + (h)) * HTB)
#define PG8_STAGE(bufoff, gbase, voff) do { _Pragma("unroll") for (int _i = 0; _i < 2; ++_i) \
        __builtin_amdgcn_global_load_lds((const unsigned*)((const char*)(gbase) + (voff)[_i]), (LAS unsigned*)(lds + (bufoff) + ldsw + _i * 8192), 16, 0, 0); } while (0)
#define PG8_LDA(dst, b, h) do { _Pragma("unroll") for (int m = 0; m < 4; ++m) _Pragma("unroll") for (int k = 0; k < 2; ++k) dst[m][k] = *(const LAS bf16x8*)(lds + PG8_SA(b, h) + aoff + m * 2048 + k * 1024); } while (0)
#define PG8_LDB(dst, b, h) do { _Pragma("unroll") for (int n = 0; n < 2; ++n) _Pragma("unroll") for (int k = 0; k < 2; ++k) dst[n][k] = *(const LAS bf16x8*)(lds + PG8_SB(b, h) + boff + n * 2048 + k * 1024); } while (0)
#define PG8_MMA(ai, bj, At, Bt) do { __builtin_amdgcn_s_setprio(1); _Pragma("unroll") for (int k = 0; k < 2; ++k) _Pragma("unroll") for (int m = 0; m < 4; ++m) _Pragma("unroll") for (int n = 0; n < 2; ++n) \
        acc[ai][bj][m][n] = __builtin_amdgcn_mfma_f32_16x16x32_bf16(Bt[n][k], At[m][k], acc[ai][bj][m][n], 0, 0, 0); __builtin_amdgcn_s_setprio(0); } while (0)
#define PG8_WAIT_V(n) asm volatile("s_waitcnt vmcnt(" #n ")" ::: "memory")
#define PG8_WAIT_L(n) asm volatile("s_waitcnt lgkmcnt(" #n ")" ::: "memory")
#define PG8_BAR __builtin_amdgcn_s_barrier()
#define PG8_SCHED __builtin_amdgcn_sched_barrier(0)
    Unit cur, nxt; int ui = 0;
    if (!S.next(0, cur)) return;
    f32x4 acc[2][2][4][2];
#pragma unroll
    for (int a = 0; a < 2; ++a)
#pragma unroll
        for (int b = 0; b < 2; ++b)
#pragma unroll
            for (int m = 0; m < 4; ++m)
#pragma unroll
                for (int n = 0; n < 2; ++n) acc[a][b][m][n] = (f32x4){0.f, 0.f, 0.f, 0.f};
    bf16x8 At[4][2], B0[2][2], B1[2][2];
    const char* cA = (const char*)g.A + (size_t)cur.pm * tstepA; const char* cB = (const char*)g.Bt + (size_t)cur.pn * tstepB;
    PG8_STAGE(PG8_SB(0, 0), cB, voffB); PG8_STAGE(PG8_SB(0, 1), cB + hstepB, voffB); PG8_STAGE(PG8_SA(0, 0), cA, voffA); PG8_STAGE(PG8_SA(0, 1), cA + hstepA, voffA);
    if (wr == 1) PG8_BAR;
    PG8_WAIT_V(2); PG8_BAR;
    PG8_STAGE(PG8_SB(1, 0), cB + kstepB, voffB); PG8_STAGE(PG8_SA(1, 0), cA + kstepA, voffA); PG8_STAGE(PG8_SB(1, 1), cB + hstepB + kstepB, voffB);
    PG8_WAIT_V(6); PG8_BAR;
    for (;;) {
        const bool has_next = S.next(ui + 1, nxt);
        const char* nA = has_next ? (const char*)g.A + (size_t)nxt.pm * tstepA : cA; const char* nB = has_next ? (const char*)g.Bt + (size_t)nxt.pn * tstepB : cB;
        for (int t = 0; t < nt; t += 2) {
            const bool last = (t == nt - 2);
            const char* a1 = cA + (size_t)(t + 1) * kstepA;
            const char* a2 = last ? nA : cA + (size_t)(t + 2) * kstepA; const char* b2 = last ? nB : cB + (size_t)(t + 2) * kstepB;
            const char* a3 = a2 + kstepA; const char* b3 = b2 + kstepB;
            PG8_LDB(B0, 0, 0); PG8_LDB(B1, 0, 1); PG8_SCHED; PG8_LDA(At, 0, 0); PG8_STAGE(PG8_SA(1, 1), a1 + hstepA, voffA);
            PG8_WAIT_V(8); PG8_WAIT_L(0); PG8_BAR; PG8_MMA(0, 0, At, B0); PG8_MMA(0, 1, At, B1); PG8_BAR; PG8_SCHED;
            PG8_LDA(At, 0, 1); PG8_STAGE(PG8_SB(0, 0), b2, voffB); PG8_STAGE(PG8_SB(0, 1), b2 + hstepB, voffB); PG8_STAGE(PG8_SA(0, 0), a2, voffA);
            PG8_WAIT_V(8); PG8_WAIT_L(0); PG8_BAR; PG8_MMA(1, 0, At, B0); PG8_MMA(1, 1, At, B1); PG8_BAR; PG8_SCHED;
            PG8_LDB(B0, 1, 0); PG8_LDB(B1, 1, 1); PG8_SCHED; PG8_LDA(At, 1, 0); PG8_STAGE(PG8_SA(0, 1), a2 + hstepA, voffA);
            PG8_WAIT_V(8); PG8_WAIT_L(0); PG8_BAR; PG8_MMA(0, 0, At, B0); PG8_MMA(0, 1, At, B1); PG8_BAR; PG8_SCHED;
            PG8_LDA(At, 1, 1); PG8_STAGE(PG8_SB(1, 0), b3, voffB); PG8_STAGE(PG8_SB(1, 1), b3 + hstepB, voffB); PG8_STAGE(PG8_SA(1, 0), a3, voffA);
            PG8_WAIT_V(8); PG8_WAIT_L(0); PG8_BAR; PG8_MMA(1, 0, At, B0); PG8_MMA(1, 1, At, B1); PG8_BAR; PG8_SCHED;
        }
        if (PG8_ALIGN) { if (wr == 0) PG8_BAR; }
        E(acc, cur, wr, wc, fr, fq);
        if (!has_next) break;
#pragma unroll
        for (int a = 0; a < 2; ++a)
#pragma unroll
            for (int b = 0; b < 2; ++b)
#pragma unroll
                for (int m = 0; m < 4; ++m)
#pragma unroll
                    for (int n = 0; n < 2; ++n) acc[a][b][m][n] = (f32x4){0.f, 0.f, 0.f, 0.f};
        cur = nxt; cA = nA; cB = nB; ++ui;
        if (PG8_ALIGN) { if (wr == 1) PG8_BAR; }
    }
    PG8_WAIT_V(0);
    if (!PG8_ALIGN) { if (wr == 0) PG8_BAR; }
    PG8_BAR;
#undef PG8_SA
#undef PG8_SB
#undef PG8_STAGE
#undef PG8_LDA
#undef PG8_LDB
#undef PG8_MMA
#undef PG8_WAIT_V
#undef PG8_WAIT_L
#undef PG8_BAR
#undef PG8_SCHED
}

constexpr int LINV_OFF = 131072 + 64, LINV_UNITS = 9;
template <int ACT> struct EpiScale {
    static constexpr bool PERM = true;
    bf16_t* O; int ldc; const LAS float* linv; int pad_tile; int otiled;
    __device__ __forceinline__ void operator()(const f32x4 (&acc)[2][2][4][2], const Unit& u, int wr, int wc, int fr, int fq) const {
        const int row0 = u.pm * BM + wr * 64 + fr, col0 = u.pn * BM + wc * 32 + 8 * fq;
        const LAS float* li = linv + u.idx * 256 + wr * 64 + fr;
#pragma unroll
        for (int ai = 0; ai < 2; ++ai)
#pragma unroll
            for (int m = 0; m < 4; ++m) {
                const int row = row0 + ai * HALF + m * 16;
                const float inv = li[ai * HALF + m * 16];
                bf16_t* rowp = otiled ? O + ((size_t)(u.pm * (ldc >> 6) + (col0 >> 6)) * BM + (row & (BM - 1))) * 64 + (col0 & 63) : O + (size_t)row * ldc + col0;
                const int bjstep = otiled ? 2 * BM * 64 : HALF;
#pragma unroll
                for (int bj = 0; bj < 2; ++bj) {
                    f32x4 v0 = acc[ai][bj][m][0] * inv, v1 = acc[ai][bj][m][1] * inv;
                    if (ACT == 1) {
#pragma unroll
                        for (int e = 0; e < 4; ++e) { const float a = fmaxf(v0[e], 0.f), b = fmaxf(v1[e], 0.f); v0[e] = a * a; v1[e] = b * b; }
                    }
                    u32x4 w; w.x = pk_bf16(v0[0], v0[1]); w.y = pk_bf16(v0[2], v0[3]); w.z = pk_bf16(v1[0], v1[1]); w.w = pk_bf16(v1[2], v1[3]);
                    if (u.pn != pad_tile || (bj == 0 && wc == 0 && fq == 0)) *(u32x4*)(rowp + bj * bjstep) = w;
                }
            }
    }
};
__device__ __forceinline__ void inv_prepass(LAS float* linv, const float* rs, const StaticOrder& S) {
    int tid_ = threadIdx.x; asm volatile("" : "+v"(tid_));
    const int r = tid_ & 255, par = tid_ >> 8;
    f32x4 p[5][4]; Unit u;
#pragma unroll
    for (int k = 0; k < 5; ++k) {
        const int i = 2 * k + par;
        const bool ok = (i < LINV_UNITS) && S.next(i, u);
#pragma unroll
        for (int q = 0; q < 4; ++q) p[k][q] = ok ? *(const f32x4*)(rs + (size_t)(u.pm * BM + r) * 16 + 4 * q) : (f32x4){0.f, 0.f, 0.f, 0.f};
    }
#pragma unroll
    for (int k = 0; k < 5; ++k) {
        const int i = 2 * k + par;
        if (i < LINV_UNITS) {
            const f32x4 t = (p[k][0] + p[k][1]) + (p[k][2] + p[k][3]);
            linv[i * 256 + r] = rsqrtf(((t[0] + t[1]) + (t[2] + t[3])) * (1.0f / 1024.0f) + EPS);
        }
    }
    __syncthreads();
}
template <int ADD> struct EpiGate {
    static constexpr bool PERM = true;
    bf16_t* O; const bf16_t* Z; int gcol;
    __device__ __forceinline__ void operator()(const f32x4 (&acc)[2][2][4][2], const Unit& u, int wr, int wc, int fr, int fq) const {
        const int row0 = u.pm * BM + wr * 64 + fr, col0 = u.pn * BM + wc * 32 + 8 * fq;
        u32x4 gq[4][2], tq[4][2];
#define EG_LOAD(ai, m) do { _Pragma("unroll") for (int bj = 0; bj < 2; ++bj) { const int row = row0 + (ai) * HALF + (m) * 16, col = col0 + bj * HALF; \
            gq[m][bj] = *(const u32x4*)(Z + (size_t)row * ZP + gcol + col); \
            if (ADD) tq[m][bj] = *(const u32x4*)(O + (size_t)row * DM + col); else tq[m][bj] = (u32x4){0u, 0u, 0u, 0u}; } } while (0)
#pragma unroll
        for (int m = 0; m < 4; ++m) EG_LOAD(0, m);
        asm volatile("" ::: "memory");
#pragma unroll
        for (int ai = 0; ai < 2; ++ai)
#pragma unroll
            for (int m = 0; m < 4; ++m) {
#pragma unroll
                for (int bj = 0; bj < 2; ++bj) {
                    const int row = row0 + ai * HALF + m * 16, col = col0 + bj * HALF;
                    const u32x4 g = gq[m][bj], t = tq[m][bj];
                    const f32x4 a0 = acc[ai][bj][m][0], a1 = acc[ai][bj][m][1];
                    u32x4 w;
                    w.x = pk_bf16(bf_lo(t.x) + sigmoidf_(bf_lo(g.x)) * a0[0], bf_hi(t.x) + sigmoidf_(bf_hi(g.x)) * a0[1]);
                    w.y = pk_bf16(bf_lo(t.y) + sigmoidf_(bf_lo(g.y)) * a0[2], bf_hi(t.y) + sigmoidf_(bf_hi(g.y)) * a0[3]);
                    w.z = pk_bf16(bf_lo(t.z) + sigmoidf_(bf_lo(g.z)) * a1[0], bf_hi(t.z) + sigmoidf_(bf_hi(g.z)) * a1[1]);
                    w.w = pk_bf16(bf_lo(t.w) + sigmoidf_(bf_lo(g.w)) * a1[2], bf_hi(t.w) + sigmoidf_(bf_hi(g.w)) * a1[3]);
                    *(u32x4*)(O + (size_t)row * DM + col) = w;
                }
                asm volatile("" ::: "memory");
                if (ai == 0) { EG_LOAD(1, m); asm volatile("" ::: "memory"); }
            }
#undef EG_LOAD
    }
};
template <int FINAL> struct EpiRes {
    static constexpr bool PERM = true;
    float* out; bf16_t* xb; float* rs;
    __device__ __forceinline__ void operator()(const f32x4 (&acc)[2][2][4][2], const Unit& u, int wr, int wc, int fr, int fq) const {
        const int row0 = u.pm * BM + wr * 64 + fr, col0 = u.pn * BM + wc * 32 + 8 * fq;
        u32x4 pre[4][2];
#define ER_LOAD(ai, m) do { _Pragma("unroll") for (int bj = 0; bj < 2; ++bj) pre[m][bj] = *(const u32x4*)(xb + (size_t)(row0 + (ai) * HALF + (m) * 16) * DM + col0 + bj * HALF); } while (0)
#pragma unroll
        for (int m = 0; m < 4; ++m) ER_LOAD(0, m);
        asm volatile("" ::: "memory");
#pragma unroll
        for (int ai = 0; ai < 2; ++ai)
#pragma unroll
            for (int m = 0; m < 4; ++m) {
                const int row = row0 + ai * HALF + m * 16; float ss = 0.f;
#pragma unroll
                for (int bj = 0; bj < 2; ++bj) {
                    const size_t off = (size_t)row * DM + col0 + bj * HALF;
                    const u32x4 b = pre[m][bj];
                    const f32x4 v0 = (f32x4){bf_lo(b.x), bf_hi(b.x), bf_lo(b.y), bf_hi(b.y)} + acc[ai][bj][m][0];
                    const f32x4 v1 = (f32x4){bf_lo(b.z), bf_hi(b.z), bf_lo(b.w), bf_hi(b.w)} + acc[ai][bj][m][1];
                    if (FINAL) { *(f32x4*)(out + off) = v0; *(f32x4*)(out + off + 4) = v1; }
                    else {
                        u32x4 w; w.x = pk_bf16(v0[0], v0[1]); w.y = pk_bf16(v0[2], v0[3]); w.z = pk_bf16(v1[0], v1[1]); w.w = pk_bf16(v1[2], v1[3]);
                        *(u32x4*)(xb + off) = w;
                        ss += (v0[0] * v0[0] + v0[1] * v0[1]) + (v0[2] * v0[2] + v0[3] * v0[3]) + (v1[0] * v1[0] + v1[1] * v1[1]) + (v1[2] * v1[2] + v1[3] * v1[3]);
                    }
                }
                if (!FINAL) {
                    ss = rowsum4(ss);
                    if (fq == 0) rs[(size_t)row * 16 + u.pn * 4 + wc] = ss;
                }
                asm volatile("" ::: "memory");
                if (ai == 0) { ER_LOAD(1, m); asm volatile("" ::: "memory"); }
            }
#undef ER_LOAD
    }
};
}

struct Args {
    const float* x; const float* norm_mix; const float* w_in; const float* qn; const float* kn; const float* sinks; const float* gbias;
    const float* hn; const float* w_ab; const float* w_mb; const float* w_out; const float* norm_ffn; const float* w1; const float* w2;
    float* out; unsigned char* ws;
    float inv_freq[8];
    int ph_lo, ph_hi;
};

typedef const __attribute__((address_space(4))) Args* KArgs;
__device__ __forceinline__ int win_map(int n) { if (n < 2304) return n; if (n < 4352) return n + 8; if (n < 4360) return n - 2048; return -1; }

__device__ __forceinline__ void tr_item(const float* W, const float* gain, bf16_t* dst, int K, int Nsrc, int mode, int item, int nNb, float* s) {
    int tid_ = threadIdx.x; asm volatile("" : "+v"(tid_));
    const int tid = tid_; const int kb = item / nNb, nb = item % nNb;
    {
        const int c = tid & 255, r0 = tid >> 8; const int nd = nb * 256 + c; const int ns = (mode & 1) ? win_map(nd) : nd;
        float v[32];
#pragma unroll
        for (int i = 0; i < 32; ++i) { const int k = kb * 64 + r0 + 2 * i; v[i] = (ns >= 0) ? W[(size_t)k * Nsrc + ns] : 0.f; }
        if (gain) {
#pragma unroll
            for (int i = 0; i < 32; ++i) v[i] *= gain[kb * 64 + r0 + 2 * i];
        }
#pragma unroll
        for (int i = 0; i < 32; ++i) s[c * 65 + r0 + 2 * i] = v[i];
    }
    __syncthreads();
    {
        const int kp = (tid & 31) * 2, r = tid >> 5;
#pragma unroll
        for (int i = 0; i < 16; ++i) {
            const int n = r + 16 * i;
            const size_t doff = (mode & 2) ? ((size_t)(nb * (K >> 6) + kb) * 256 + n) * 64 + kp : (size_t)(nb * 256 + n) * K + kb * 64 + kp;
            *(unsigned*)(dst + doff) = pk_bf16(s[n * 65 + kp], s[n * 65 + kp + 1]);
        }
    }
    __syncthreads();
}

__device__ __forceinline__ void sincos_acc(double a, float& c, float& s) {
    const double q = rint(a * 0.63661977236758134308); const double r = a - q * 1.57079632679489661923; const int qi = ((int)q) & 3;
    const double r2 = r * r;
    const double sn = r * (1.0 + r2 * (-1.0 / 6.0 + r2 * (1.0 / 120.0 + r2 * (-1.0 / 5040.0 + r2 * (1.0 / 362880.0 + r2 * (-1.0 / 39916800.0))))));
    const double cs = 1.0 + r2 * (-0.5 + r2 * (1.0 / 24.0 + r2 * (-1.0 / 720.0 + r2 * (1.0 / 40320.0 + r2 * (-1.0 / 3628800.0 + r2 * (1.0 / 479001600.0))))));
    if (qi == 0) { c = (float)cs; s = (float)sn; } else if (qi == 1) { c = (float)(-sn); s = (float)cs; } else if (qi == 2) { c = (float)(-cs); s = (float)(-sn); } else { c = (float)sn; s = (float)(-cs); }
}

__device__ __forceinline__ void prologue(KArgs P, unsigned char* lds) {
    int tid_ = threadIdx.x; asm volatile("" : "+v"(tid_));
    const int tid = tid_, lane = tid & 63, wave = tid >> 6, G = gridDim.x;
    float* s = (float*)lds;
    constexpr int I_IN = 16 * 18, I_AB = 8 * 4, I_MB = 8 * 4, I_OUT = 16 * 4, I_1 = 16 * 16, I_2 = 64 * 4, I_L = I_IN + I_AB + I_MB + I_OUT + I_1 + I_2;
    for (int it = blockIdx.x; it < DEPTH * I_L; it += G) {
        const int l = it / I_L; int r = it % I_L;
        unsigned char* wl = gptr(P->ws) + WS_W + (size_t)l * WL_SIZE;
        if (r < I_IN) { tr_item(gptr(P->w_in) + (size_t)l * DM * DIN_SRC, gptr(P->norm_mix) + l * DM, (bf16_t*)(wl + WL_IN), DM, DIN_SRC, 1, r, 18, s); continue; } r -= I_IN;
        if (r < I_AB) { tr_item(gptr(P->w_ab) + (size_t)l * 512 * DM, nullptr, (bf16_t*)(wl + WL_AB), 512, DM, 0, r, 4, s); continue; } r -= I_AB;
        if (r < I_MB) { tr_item(gptr(P->w_mb) + (size_t)l * 512 * DM, nullptr, (bf16_t*)(wl + WL_MB), 512, DM, 0, r, 4, s); continue; } r -= I_MB;
        if (r < I_OUT) { tr_item(gptr(P->w_out) + (size_t)l * DM * DM, nullptr, (bf16_t*)(wl + WL_OUT), DM, DM, 0, r, 4, s); continue; } r -= I_OUT;
        if (r < I_1) { tr_item(gptr(P->w1) + (size_t)l * DM * DFF, gptr(P->norm_ffn) + l * DM, (bf16_t*)(wl + WL_1), DM, DFF, 0, r, 16, s); continue; } r -= I_1;
        tr_item(gptr(P->w2) + (size_t)l * DFF * DM, nullptr, (bf16_t*)(wl + WL_2), DFF, DM, 2, r, 4, s);
    }
    {
        bf16_t* xb = (bf16_t*)(gptr(P->ws) + WS_XB); float* rs = (float*)(gptr(P->ws) + WS_RS);
        const int gw = blockIdx.x * 8 + wave, NGW = G * 8;
        for (int row0 = gw * 4; row0 < MROWS; row0 += NGW * 4) {
            f32x4 v[4][4];
#pragma unroll
            for (int rr = 0; rr < 4; ++rr) { const f32x4* xr = (const f32x4*)(gptr(P->x) + (size_t)(row0 + rr) * DM) + lane;
#pragma unroll
                for (int j = 0; j < 4; ++j) v[rr][j] = xr[64 * j]; }
#pragma unroll
            for (int rr = 0; rr < 4; ++rr) {
                const int row = row0 + rr; float ss = 0.f;
#pragma unroll
                for (int j = 0; j < 4; ++j) ss += (v[rr][j][0] * v[rr][j][0] + v[rr][j][1] * v[rr][j][1]) + (v[rr][j][2] * v[rr][j][2] + v[rr][j][3] * v[rr][j][3]);
                ss = wave_sum(ss);
                u32x2* o = (u32x2*)(xb + (size_t)row * DM) + lane;
#pragma unroll
                for (int j = 0; j < 4; ++j) { u32x2 w; w.x = pk_bf16(v[rr][j][0], v[rr][j][1]); w.y = pk_bf16(v[rr][j][2], v[rr][j][3]); o[64 * j] = w; }
                if (lane < 4) { f32x4 z = {0.f, 0.f, 0.f, 0.f}; if (lane == 0) z[0] = ss; *((f32x4*)(rs + (size_t)row * 16) + lane) = z; }
            }
        }
    }
    {
        f32x2* rope = (f32x2*)(gptr(P->ws) + WS_ROPE);
        for (int e = blockIdx.x * 512 + tid; e < SEQ * 8; e += G * 512) {
            const int pos = e >> 3, i = e & 7; const float ang = (float)pos * P->inv_freq[i];
            float c, sn; sincos_acc((double)ang, c, sn); rope[e] = (f32x2){c, sn};
        }
    }
}

__device__ __forceinline__ void attn_item(unsigned char* lds, bf16_t* Z, const f32x2* rope, const float* qn, const float* kn, const float* sinks, int item) {
    int tid_ = threadIdx.x; asm volatile("" : "+v"(tid_));
    const int tid = tid_, lane = tid & 63, w = __builtin_amdgcn_readfirstlane(tid >> 6), l15 = lane & 15, g = lane >> 4;
    const int kvh = item & 1, n = (item >> 1) & 31, b = item >> 6;
    bf16_t* Ks = (bf16_t*)lds;
    bf16_t* VT = (bf16_t*)(lds + 256 * 144);
    const size_t rowbase = (size_t)b * SEQ;
    const int pos0 = 128 * (n - 1);
    const int qpos = 128 * n + 16 * w + l15;
    const size_t grow = rowbase + qpos;
    u32x4 qn0, qn1;
    { const bf16_t* q0 = Z + grow * ZP + ZC_QA + (kvh * 4) * 64 + 8 * g; qn0 = *(const u32x4*)(q0); qn1 = *(const u32x4*)(q0 + 32); }
    if (tid < 256) {
        const int key = tid, pos = pos0 + key;
        u32x4 raw[8];
        if (pos >= 0) {
            const u32x4* src = (const u32x4*)(Z + (rowbase + pos) * ZP + ZC_KA + kvh * 64);
#pragma unroll
            for (int i = 0; i < 8; ++i) raw[i] = src[i];
        } else {
#pragma unroll
            for (int i = 0; i < 8; ++i) raw[i] = (u32x4){0u, 0u, 0u, 0u};
        }
        float ss = 0.f;
#pragma unroll
        for (int i = 0; i < 8; ++i) { const u32x4 r = raw[i];
            ss += bf_lo(r.x) * bf_lo(r.x) + bf_hi(r.x) * bf_hi(r.x) + bf_lo(r.y) * bf_lo(r.y) + bf_hi(r.y) * bf_hi(r.y) + bf_lo(r.z) * bf_lo(r.z) + bf_hi(r.z) * bf_hi(r.z) + bf_lo(r.w) * bf_lo(r.w) + bf_hi(r.w) * bf_hi(r.w); }
        const float inv = rsqrtf(ss * (1.0f / 64.0f) + EPS);
        const int pp = pos >= 0 ? pos : 0;
        u32x4* dst = (u32x4*)(Ks + key * 72);
        {
            float a[8], bq[8];
            { const u32x4 r = raw[0]; a[0] = bf_lo(r.x); a[1] = bf_hi(r.x); a[2] = bf_lo(r.y); a[3] = bf_hi(r.y); a[4] = bf_lo(r.z); a[5] = bf_hi(r.z); a[6] = bf_lo(r.w); a[7] = bf_hi(r.w); }
            { const u32x4 r = raw[1]; bq[0] = bf_lo(r.x); bq[1] = bf_hi(r.x); bq[2] = bf_lo(r.y); bq[3] = bf_hi(r.y); bq[4] = bf_lo(r.z); bq[5] = bf_hi(r.z); bq[6] = bf_lo(r.w); bq[7] = bf_hi(r.w); }
#pragma unroll
            for (int i = 0; i < 8; ++i) { const f32x2 cs = rope[pp * 8 + i]; const float x1 = a[i] * inv * kn[i], x2 = bq[i] * inv * kn[8 + i]; a[i] = x1 * cs[0] - x2 * cs[1]; bq[i] = x2 * cs[0] + x1 * cs[1]; }
            u32x4 r; r.x = pk_bf16(a[0], a[1]); r.y = pk_bf16(a[2], a[3]); r.z = pk_bf16(a[4], a[5]); r.w = pk_bf16(a[6], a[7]); dst[0] = r;
            r.x = pk_bf16(bq[0], bq[1]); r.y = pk_bf16(bq[2], bq[3]); r.z = pk_bf16(bq[4], bq[5]); r.w = pk_bf16(bq[6], bq[7]); dst[1] = r;
        }
#pragma unroll
        for (int i = 2; i < 8; ++i) { const u32x4 r = raw[i]; const float* kg = kn + 8 * i; u32x4 o;
            o.x = pk_bf16(bf_lo(r.x) * inv * kg[0], bf_hi(r.x) * inv * kg[1]); o.y = pk_bf16(bf_lo(r.y) * inv * kg[2], bf_hi(r.y) * inv * kg[3]);
            o.z = pk_bf16(bf_lo(r.z) * inv * kg[4], bf_hi(r.z) * inv * kg[5]); o.w = pk_bf16(bf_lo(r.w) * inv * kg[6], bf_hi(r.w) * inv * kg[7]); dst[i] = o; }
    } else {
        const int key = tid - 256, pos = pos0 + key;
        const u32x4* src = (const u32x4*)(Z + (rowbase + (pos >= 0 ? pos : 0)) * ZP + ZC_VA + kvh * 64);
#pragma unroll
        for (int i = 0; i < 8; ++i) {
            u32x4 r = src[i]; if (pos < 0) r = (u32x4){0u, 0u, 0u, 0u};
            VT[(8 * i + 0) * 264 + key] = (bf16_t)(r.x & 0xffffu); VT[(8 * i + 1) * 264 + key] = (bf16_t)(r.x >> 16);
            VT[(8 * i + 2) * 264 + key] = (bf16_t)(r.y & 0xffffu); VT[(8 * i + 3) * 264 + key] = (bf16_t)(r.y >> 16);
            VT[(8 * i + 4) * 264 + key] = (bf16_t)(r.z & 0xffffu); VT[(8 * i + 5) * 264 + key] = (bf16_t)(r.z >> 16);
            VT[(8 * i + 6) * 264 + key] = (bf16_t)(r.w & 0xffffu); VT[(8 * i + 7) * 264 + key] = (bf16_t)(r.w >> 16);
        }
    }
    __syncthreads();
#pragma unroll 2
    for (int hh = 0; hh < 4; ++hh) {
        const int head = kvh * 4 + hh;
        bf16_t* qptr = Z + grow * ZP + ZC_QA + head * 64;
        float xq[2][8];
        const u32x4 qr0 = qn0, qr1 = qn1;
        if (hh < 3) { qn0 = *(const u32x4*)(qptr + 64 + 8 * g); qn1 = *(const u32x4*)(qptr + 64 + 32 + 8 * g); }
#pragma unroll
        for (int kk = 0; kk < 2; ++kk) { const u32x4 r = kk == 0 ? qr0 : qr1;
            xq[kk][0] = bf_lo(r.x); xq[kk][1] = bf_hi(r.x); xq[kk][2] = bf_lo(r.y); xq[kk][3] = bf_hi(r.y); xq[kk][4] = bf_lo(r.z); xq[kk][5] = bf_hi(r.z); xq[kk][6] = bf_lo(r.w); xq[kk][7] = bf_hi(r.w); }
        float ss = 0.f;
#pragma unroll
        for (int kk = 0; kk < 2; ++kk)
#pragma unroll
            for (int i = 0; i < 8; ++i) ss += xq[kk][i] * xq[kk][i];
        ss = rowsum4(ss);
        const float inv = rsqrtf(ss * (1.0f / 64.0f) + EPS);
#pragma unroll
        for (int kk = 0; kk < 2; ++kk)
#pragma unroll
            for (int i = 0; i < 8; ++i) xq[kk][i] = xq[kk][i] * inv * qn[32 * kk + 8 * g + i];
#pragma unroll
        for (int i = 0; i < 8; ++i) {
            const auto pr = __builtin_amdgcn_permlane16_swap(__float_as_uint(xq[0][i]), __float_as_uint(xq[0][i]), false, false);
            const float other = __uint_as_float((g & 1) ? pr[0] : pr[1]); const f32x2 cs = rope[qpos * 8 + i];
            if (g == 0) xq[0][i] = xq[0][i] * cs[0] - other * cs[1];
            else if (g == 1) xq[0][i] = xq[0][i] * cs[0] + other * cs[1];
        }
        bf16x8 qf[2];
#pragma unroll
        for (int kk = 0; kk < 2; ++kk) { u32x4 r; const float qsc = 0.125f * 1.4426950408889634f; r.x = pk_bf16(xq[kk][0] * qsc, xq[kk][1] * qsc); r.y = pk_bf16(xq[kk][2] * qsc, xq[kk][3] * qsc); r.z = pk_bf16(xq[kk][4] * qsc, xq[kk][5] * qsc); r.w = pk_bf16(xq[kk][6] * qsc, xq[kk][7] * qsc); qf[kk] = __builtin_bit_cast(bf16x8, r); }
        f32x4 sc[9];
#pragma unroll
        for (int t = 0; t < 9; ++t) {
            const int kt = w + t;
            const bf16x8 a0 = *(const bf16x8*)(Ks + (16 * kt + l15) * 72 + 8 * g), a1 = *(const bf16x8*)(Ks + (16 * kt + l15) * 72 + 32 + 8 * g);
            f32x4 c = {0.f, 0.f, 0.f, 0.f};
            c = __builtin_amdgcn_mfma_f32_16x16x32_bf16(a0, qf[0], c, 0, 0, 0);
            c = __builtin_amdgcn_mfma_f32_16x16x32_bf16(a1, qf[1], c, 0, 0, 0);
            sc[t] = c;
        }
        const float sink = sinks[head] * 1.4426950408889634f;
        float mx = sink;
        const int dlt = 4 * g - l15;
#pragma unroll
        for (int t = 0; t < 9; ++t) {
            const bool tile_ok = (n > 0) || (w + t >= 8);
#pragma unroll
            for (int j = 0; j < 4; ++j) {
                bool valid = tile_ok;
                if (t == 0) valid = valid && (dlt + j > 0);
                if (t == 8) valid = (dlt + j <= 0);
                sc[t][j] = valid ? sc[t][j] : -INFINITY;
                mx = fmaxf(mx, sc[t][j]);
            }
        }
        mx = rowmax4(mx);
        float sum = 0.f;
#pragma unroll
        for (int t = 0; t < 9; ++t)
#pragma unroll
            for (int j = 0; j < 4; ++j) { const float p = __builtin_amdgcn_exp2f(sc[t][j] - mx); sc[t][j] = p; sum += p; }
        sum = rowsum4(sum);
        const float rden = __builtin_amdgcn_rcpf(sum + __builtin_amdgcn_exp2f(sink - mx));
        f32x4 o[4];
#pragma unroll
        for (int dt = 0; dt < 4; ++dt) o[dt] = (f32x4){0.f, 0.f, 0.f, 0.f};
#pragma unroll
        for (int pp = 0; pp < 5; ++pp) {
            const int t0 = 2 * pp, t1 = (2 * pp + 1 < 9) ? 2 * pp + 1 : 2 * pp;
            u32x4 pb; pb.x = pk_bf16(sc[t0][0] * rden, sc[t0][1] * rden); pb.y = pk_bf16(sc[t0][2] * rden, sc[t0][3] * rden);
            if (2 * pp + 1 < 9) { pb.z = pk_bf16(sc[t1][0] * rden, sc[t1][1] * rden); pb.w = pk_bf16(sc[t1][2] * rden, sc[t1][3] * rden); } else { pb.z = 0u; pb.w = 0u; }
            const bf16x8 bfrag = __builtin_bit_cast(bf16x8, pb);
            const int k0 = 16 * (w + t0) + 4 * g, k1 = 16 * (w + t1) + 4 * g;
#pragma unroll
            for (int dt = 0; dt < 4; ++dt) {
                const bf16_t* vr = VT + (16 * dt + l15) * 264;
                const u32x2 lo = *(const u32x2*)(vr + k0), hi = *(const u32x2*)(vr + k1);
                const u32x4 av = {lo.x, lo.y, hi.x, hi.y};
                o[dt] = __builtin_amdgcn_mfma_f32_16x16x32_bf16(__builtin_bit_cast(bf16x8, av), bfrag, o[dt], 0, 0, 0);
            }
        }
#pragma unroll
        for (int dt = 0; dt < 4; ++dt) { u32x2 r; r.x = pk_bf16(o[dt][0], o[dt][1]); r.y = pk_bf16(o[dt][2], o[dt][3]); *(u32x2*)(qptr + 16 * dt + 4 * g) = r; }
    }
    __syncthreads();
}

__device__ __forceinline__ float logsigmoidf_(float x) { return fminf(x, 0.f) - __logf(1.0f + __expf(-fabsf(x))); }

__device__ __forceinline__ void m1_item4(unsigned char* lds, const bf16_t* Z, const float* gbias, bf16_t* dC, float* dn, float* gArr, float* mlArr, int item4) {
    int tid_ = threadIdx.x; asm volatile("" : "+v"(tid_));
    const int tid = tid_, lane = tid & 63, w = __builtin_amdgcn_readfirstlane(tid >> 6), l15 = lane & 15, g = lane >> 4;
    const int c = item4 & 63, b = item4 >> 6;
    const size_t rowbase = (size_t)b * SEQ + c * 64;
    constexpr int HB = 28160;
    const int t = tid & 63, pc = tid >> 6;
    const bf16_t* zr = Z + (rowbase + t) * ZP;
    u32x4 rk[4], rv0[4], rv1[4];
#pragma unroll
    for (int j = 0; j < 4; ++j) {
        rk[j] = *(const u32x4*)(zr + ZC_KM + j * 64 + 8 * pc);
        rv0[j] = *(const u32x4*)(zr + ZC_VM + j * 128 + 8 * pc);
        rv1[j] = *(const u32x4*)(zr + ZC_VM + j * 128 + 8 * (pc + 8));
    }
    if (w < 4) {
        const int h = w;
        const u32x4 gq = *(const u32x4*)(zr + ZC_IF);
        const unsigned iw = (h < 2) ? gq.x : gq.y, fw = (h < 2) ? gq.z : gq.w;
        const float ipre = ((h & 1) ? bf_hi(iw) : bf_lo(iw)) + gbias[h], fpre = ((h & 1) ? bf_hi(fw) : bf_lo(fw)) + gbias[4 + h];
        float v = logsigmoidf_(fpre);
#pragma unroll
        for (int o = 1; o < 64; o <<= 1) { const float u = __shfl_up(v, o); if (lane >= o) v += u; }
        const float gt = __shfl(v, 63);
        const float wend = gt - v + ipre;
        const float ml = wave_max(wend);
        ((float*)(lds + h * HB))[lane] = __expf(wend - ml);
        if (lane == 0) { gArr[item4 * 4 + h] = gt; mlArr[item4 * 4 + h] = ml; }
    }
    __syncthreads();
#pragma unroll
    for (int j = 0; j < 4; ++j) {
        const float e = ((const float*)(lds + j * HB))[t];
        bf16_t* KT = (bf16_t*)(lds + j * HB + 256); bf16_t* VT = KT + 64 * 72;
        const u32x4 r = rk[j];
        const unsigned p0 = pk_bf16(bf_lo(r.x) * e, bf_hi(r.x) * e), p1 = pk_bf16(bf_lo(r.y) * e, bf_hi(r.y) * e), p2 = pk_bf16(bf_lo(r.z) * e, bf_hi(r.z) * e), p3 = pk_bf16(bf_lo(r.w) * e, bf_hi(r.w) * e);
        bf16_t* d = KT + (8 * pc) * 72 + t;
        d[0] = (bf16_t)(p0 & 0xffffu); d[72] = (bf16_t)(p0 >> 16); d[144] = (bf16_t)(p1 & 0xffffu); d[216] = (bf16_t)(p1 >> 16);
        d[288] = (bf16_t)(p2 & 0xffffu); d[360] = (bf16_t)(p2 >> 16); d[432] = (bf16_t)(p3 & 0xffffu); d[504] = (bf16_t)(p3 >> 16);
#pragma unroll
        for (int rep = 0; rep < 2; ++rep) {
            const int pv = pc + 8 * rep;
            const u32x4 q = rep == 0 ? rv0[j] : rv1[j];
            bf16_t* dv = VT + (8 * pv) * 72 + t;
            dv[0] = (bf16_t)(q.x & 0xffffu); dv[72] = (bf16_t)(q.x >> 16); dv[144] = (bf16_t)(q.y & 0xffffu); dv[216] = (bf16_t)(q.y >> 16);
            dv[288] = (bf16_t)(q.z & 0xffffu); dv[360] = (bf16_t)(q.z >> 16); dv[432] = (bf16_t)(q.w & 0xffffu); dv[504] = (bf16_t)(q.w >> 16);
        }
    }
    __syncthreads();
#pragma unroll
    for (int j = 0; j < 4; ++j) {
        const bf16_t* KT = (const bf16_t*)(lds + j * HB + 256); const bf16_t* VT = KT + 64 * 72;
        const bf16_t* ar = VT + (16 * w + l15) * 72 + 8 * g;
        const bf16x8 a0 = *(const bf16x8*)(ar), a1 = *(const bf16x8*)(ar + 32);
        bf16_t* dst = dC + (size_t)(item4 * 4 + j) * 8192 + (16 * w + l15) * 64 + 4 * g;
#pragma unroll
        for (int kt = 0; kt < 4; ++kt) {
            const bf16_t* br = KT + (16 * kt + l15) * 72 + 8 * g;
            const bf16x8 b0 = *(const bf16x8*)(br), b1 = *(const bf16x8*)(br + 32);
            f32x4 acc = {0.f, 0.f, 0.f, 0.f};
            acc = __builtin_amdgcn_mfma_f32_16x16x32_bf16(b0, a0, acc, 0, 0, 0);
            acc = __builtin_amdgcn_mfma_f32_16x16x32_bf16(b1, a1, acc, 0, 0, 0);
            u32x2 o; o.x = pk_bf16(acc[0], acc[1]); o.y = pk_bf16(acc[2], acc[3]);
            *(u32x2*)(dst + 16 * kt) = o;
        }
    }
    if (tid < 256) {
        const int j = tid >> 6, k = tid & 63;
        float s = 0.f; const bf16_t* kr = (const bf16_t*)(lds + j * HB + 256) + k * 72;
#pragma unroll 8
        for (int tt = 0; tt < 64; ++tt) s += bf2f(kr[tt]);
        dn[(size_t)(item4 * 4 + j) * 64 + k] = s;
    }
    __syncthreads();
}

__device__ __forceinline__ float rdlane(float v, int l) { return __int_as_float(__builtin_amdgcn_readlane(__float_as_int(v), l)); }
__device__ __forceinline__ void scan_item(unsigned char* lds, unsigned* dC, float* dn, const float* gArr, const float* mlArr, float* mp, int item) {
    int tid_ = threadIdx.x; asm volatile("" : "+v"(tid_));
    const int tid = tid_, lane = tid & 63;
    const int bh = item >> 3, sl = item & 7, b = bh >> 2, h = bh & 3;
    const int base_idx = (b * NCH) * 4 + h;
    float* sa_ = (float*)lds; float* ss_ = sa_ + 64;
    if (tid < 64) {
        const float gv = gArr[base_idx + 4 * lane], mlv = mlArr[base_idx + 4 * lane];
        float av = 0.f, sv = 0.f, mv = 0.f, m = 0.f;
#pragma unroll
        for (int c = 0; c < 64; ++c) {
            const float gc = rdlane(gv, c), ml = rdlane(mlv, c);
            const float mnew = fmaxf(gc + m, ml);
            const float a = __expf(gc + m - mnew), s_ = __expf(ml - mnew);
            if (lane == c) { av = a; sv = s_; mv = m; }
            m = mnew;
        }
        sa_[lane] = av; ss_[lane] = sv;
        if (sl == 0) mp[base_idx + 4 * lane] = mv;
    }
    __syncthreads();
    const bool do_n = (sl == 0) && (tid < 64);
    unsigned* p = dC + (size_t)base_idx * 4096 + sl * 512 + tid;
    float* pn = dn + (size_t)base_idx * 64 + (tid & 63);
    float C0 = 0.f, C1 = 0.f, nst = 0.f;
    unsigned cv[8]; float cnv[8];
#pragma unroll
    for (int i = 0; i < 8; ++i) { cv[i] = p[(size_t)i * 16384]; cnv[i] = do_n ? pn[i * 256] : 0.f; }
#pragma unroll
    for (int cg = 0; cg < 8; ++cg) {
        unsigned nv[8]; float nnv[8];
        if (cg < 7) {
#pragma unroll
            for (int i = 0; i < 8; ++i) { const int c = cg * 8 + 8 + i; nv[i] = p[(size_t)c * 16384]; nnv[i] = do_n ? pn[c * 256] : 0.f; }
        }
        asm volatile("" ::: "memory");
#pragma unroll
        for (int i = 0; i < 8; ++i) {
            const int c = cg * 8 + i;
            const float a = sa_[c], s_ = ss_[c];
            p[(size_t)c * 16384] = pk_bf16(C0, C1); if (do_n) pn[c * 256] = nst;
            C0 = a * C0 + s_ * bf_lo(cv[i]); C1 = a * C1 + s_ * bf_hi(cv[i]); nst = a * nst + s_ * cnv[i];
        }
        if (cg < 7) {
#pragma unroll
            for (int i = 0; i < 8; ++i) { cv[i] = nv[i]; cnv[i] = nnv[i]; }
        }
    }
    __syncthreads();
}

__device__ __forceinline__ void m3_item(unsigned char* lds, bf16_t* Z, const float* gbias, const float* hn, const bf16_t* Cp, const float* np, const float* mp, int item) {
    int tid_ = threadIdx.x; asm volatile("" : "+v"(tid_));
    const int tid = tid_, lane = tid & 63, w = __builtin_amdgcn_readfirstlane(tid >> 6), l15 = lane & 15, g = lane >> 4;
    const int hp = item & 1, c = (item >> 1) & 63, b = item >> 7;
    const int gr = w >> 2, tt = w & 3, h = 2 * hp + gr, tg = tid & 255;
    const int idx = (b * NCH + c) * 4 + h;
    const size_t rowbase = (size_t)b * SEQ + c * 64;
    unsigned char* gl = lds + gr * 20480;
    bf16_t* VT = (bf16_t*)gl;
    float* sb = (float*)(gl + 18432);
    float* su = sb + 64;
    float* sm = sb + 128;
    float* sa = sb + 192;
    const int t = 16 * tt + l15;
    bf16_t* zrow = Z + (rowbase + t) * ZP;
    u32x4 vq[4];
#pragma unroll
    for (int rep = 0; rep < 4; ++rep) vq[rep] = *(const u32x4*)(Z + (rowbase + (tg & 63)) * ZP + ZC_VM + h * 128 + 8 * ((tg >> 6) + 4 * rep));
    unsigned ifp = 0u; float mprev = 0.f;
    if (tt == 0) { const bf16_t* zr = Z + (rowbase + lane) * ZP + ZC_IF; ifp = (unsigned)zr[h] | ((unsigned)zr[4 + h] << 16); mprev = mp[idx]; }
    u32x4 qraw[2];
#pragma unroll
    for (int kk = 0; kk < 2; ++kk) qraw[kk] = *(const u32x4*)(zrow + ZC_QM + h * 64 + 8 * g + 32 * kk);
    u32x4 kraw[4][2];
#pragma unroll
    for (int st = 0; st < 4; ++st)
#pragma unroll
        for (int kk = 0; kk < 2; ++kk) {
            kraw[st][kk] = (u32x4){0u, 0u, 0u, 0u};
            if (st <= tt) kraw[st][kk] = *(const u32x4*)(Z + (rowbase + 16 * st + l15) * ZP + ZC_KM + h * 64 + 8 * g + 32 * kk);
        }
    u32x2 og[8];
#pragma unroll
    for (int vt = 0; vt < 8; ++vt) og[vt] = *(const u32x2*)(zrow + ZC_OM + h * 128 + 16 * vt + 4 * g);
    const bf16_t* cb = Cp + (size_t)idx * 8192 + l15 * 64 + 8 * g;
    u32x4 cpre[8][2];
#pragma unroll
    for (int vt = 0; vt < 8; ++vt)
#pragma unroll
        for (int kk = 0; kk < 2; ++kk) cpre[vt][kk] = *(const u32x4*)(cb + vt * 1024 + 32 * kk);
    f32x4 npre[2][2];
#pragma unroll
    for (int kk = 0; kk < 2; ++kk) { npre[kk][0] = (f32x4){0.f, 0.f, 0.f, 0.f}; npre[kk][1] = npre[kk][0];
        if (l15 == 0) { npre[kk][0] = *(const f32x4*)(np + (size_t)idx * 64 + 32 * kk + 8 * g); npre[kk][1] = *(const f32x4*)(np + (size_t)idx * 64 + 32 * kk + 8 * g + 4); } }
    if (tt == 0) {
        const float ipre = bf_lo(ifp) + gbias[h], fpre = bf_hi(ifp) + gbias[4 + h];
        float v = logsigmoidf_(fpre);
#pragma unroll
        for (int o = 1; o < 64; o <<= 1) { const float u = __shfl_up(v, o); if (lane >= o) v += u; }
        const float u = ipre - v;
        float pm = u;
#pragma unroll
        for (int o = 1; o < 64; o <<= 1) { const float q = __shfl_up(pm, o); if (lane >= o) pm = fmaxf(pm, q); }
        const float mt = v + fmaxf(mprev, pm);
        sb[lane] = v; su[lane] = u; sm[lane] = mt; sa[lane] = __expf(v + mprev - mt);
    }
    {
        const int ts = tg & 63;
#pragma unroll
        for (int rep = 0; rep < 4; ++rep) {
            const int pv = (tg >> 6) + 4 * rep;
            const u32x4 q = vq[rep];
            bf16_t* dv = VT + (8 * pv) * 72 + ts;
            dv[0] = (bf16_t)(q.x & 0xffffu); dv[72] = (bf16_t)(q.x >> 16); dv[144] = (bf16_t)(q.y & 0xffffu); dv[216] = (bf16_t)(q.y >> 16);
            dv[288] = (bf16_t)(q.z & 0xffffu); dv[360] = (bf16_t)(q.z >> 16); dv[432] = (bf16_t)(q.w & 0xffffu); dv[504] = (bf16_t)(q.w >> 16);
        }
    }
    __syncthreads();
    {
        const float bt = sb[t], mt = sm[t], at = sa[t];
        bf16x8 qf[2], qs[2];
#pragma unroll
        for (int kk = 0; kk < 2; ++kk) {
            const u32x4 r = qraw[kk]; qf[kk] = __builtin_bit_cast(bf16x8, r);
            const float sc = at * 0.125f; u32x4 s;
            s.x = pk_bf16(bf_lo(r.x) * sc, bf_hi(r.x) * sc); s.y = pk_bf16(bf_lo(r.y) * sc, bf_hi(r.y) * sc); s.z = pk_bf16(bf_lo(r.z) * sc, bf_hi(r.z) * sc); s.w = pk_bf16(bf_lo(r.w) * sc, bf_hi(r.w) * sc);
            qs[kk] = __builtin_bit_cast(bf16x8, s);
        }
        f32x4 wv[4]; float dsum = 0.f;
#pragma unroll
        for (int st = 0; st < 4; ++st) {
            wv[st] = (f32x4){0.f, 0.f, 0.f, 0.f};
            if (st <= tt) {
                f32x4 s = {0.f, 0.f, 0.f, 0.f};
                s = __builtin_amdgcn_mfma_f32_16x16x32_bf16(__builtin_bit_cast(bf16x8, kraw[st][0]), qf[0], s, 0, 0, 0);
                s = __builtin_amdgcn_mfma_f32_16x16x32_bf16(__builtin_bit_cast(bf16x8, kraw[st][1]), qf[1], s, 0, 0, 0);
#pragma unroll
                for (int j = 0; j < 4; ++j) {
                    const int sp = 16 * st + 4 * g + j;
                    const float wgt = (sp <= t) ? __expf(bt + su[sp] - mt) * s[j] * 0.125f : 0.f;
                    wv[st][j] = wgt; dsum += wgt;
                }
            }
        }
        dsum = rowsum4(dsum);
        f32x4 num[8];
#pragma unroll
        for (int vt = 0; vt < 8; ++vt) num[vt] = (f32x4){0.f, 0.f, 0.f, 0.f};
#pragma unroll
        for (int vt = 0; vt < 8; ++vt)
#pragma unroll
            for (int kk = 0; kk < 2; ++kk) num[vt] = __builtin_amdgcn_mfma_f32_16x16x32_bf16(__builtin_bit_cast(bf16x8, cpre[vt][kk]), qs[kk], num[vt], 0, 0, 0);
        f32x4 nacc = {0.f, 0.f, 0.f, 0.f};
#pragma unroll
        for (int kk = 0; kk < 2; ++kk) {
            const f32x4 c0 = npre[kk][0], c1 = npre[kk][1];
            u32x4 cv; cv.x = pk_bf16(c0[0], c0[1]); cv.y = pk_bf16(c0[2], c0[3]); cv.z = pk_bf16(c1[0], c1[1]); cv.w = pk_bf16(c1[2], c1[3]);
            nacc = __builtin_amdgcn_mfma_f32_16x16x32_bf16(__builtin_bit_cast(bf16x8, cv), qs[kk], nacc, 0, 0, 0);
        }
        const float nq = __shfl(nacc[0], l15);
#pragma unroll
        for (int k2 = 0; k2 < 2; ++k2) {
            if (2 * k2 <= tt) {
                u32x4 pb; pb.x = pk_bf16(wv[2 * k2][0], wv[2 * k2][1]); pb.y = pk_bf16(wv[2 * k2][2], wv[2 * k2][3]); pb.z = pk_bf16(wv[2 * k2 + 1][0], wv[2 * k2 + 1][1]); pb.w = pk_bf16(wv[2 * k2 + 1][2], wv[2 * k2 + 1][3]);
                const bf16x8 bfrag = __builtin_bit_cast(bf16x8, pb);
#pragma unroll
                for (int vt = 0; vt < 8; ++vt) {
                    const bf16_t* vr = VT + (16 * vt + l15) * 72 + 32 * k2 + 4 * g;
                    const u32x2 lo = *(const u32x2*)(vr), hi = *(const u32x2*)(vr + 16);
                    const u32x4 av = {lo.x, lo.y, hi.x, hi.y};
                    num[vt] = __builtin_amdgcn_mfma_f32_16x16x32_bf16(__builtin_bit_cast(bf16x8, av), bfrag, num[vt], 0, 0, 0);
                }
            }
        }
        const float den = dsum + nq;
        const float rd = __builtin_amdgcn_rcpf(fmaxf(fabsf(den), __expf(-mt)));
        float ss = 0.f;
#pragma unroll
        for (int vt = 0; vt < 8; ++vt) { num[vt] = num[vt] * rd; ss += (num[vt][0] * num[vt][0] + num[vt][1] * num[vt][1]) + (num[vt][2] * num[vt][2] + num[vt][3] * num[vt][3]); }
        ss = rowsum4(ss);
        const float rinv = rsqrtf(ss * (1.0f / 128.0f) + EPS);
#pragma unroll
        for (int vt = 0; vt < 8; ++vt) {
            const int v0 = h * 128 + 16 * vt + 4 * g;
            const f32x4 gn = *(const f32x4*)(hn + v0);
            const u32x2 o2 = og[vt];
            u32x2 r;
            r.x = pk_bf16(num[vt][0] * rinv * gn[0] * sigmoidf_(bf_lo(o2.x)), num[vt][1] * rinv * gn[1] * sigmoidf_(bf_hi(o2.x)));
            r.y = pk_bf16(num[vt][2] * rinv * gn[2] * sigmoidf_(bf_lo(o2.y)), num[vt][3] * rinv * gn[3] * sigmoidf_(bf_hi(o2.y)));
            *(u32x2*)(zrow + ZC_VM + v0) = r;
        }
    }
    __syncthreads();
}

#define XB_TMO      128
#define XB_XCNT(j)  (256  + 64 * (j))
#define XB_XSUB(j)  (1280 + 64 * (j))
#define XB_XGEN(j)  (2304 + 64 * (j))
#define XB_TOP      3328
#define XB_TOPGEN   3392
#define XCD_BAR_WORDS 3456
#define XB_SPIN_CAP (1u << 18)
__device__ __forceinline__ unsigned xb_ld(unsigned* p)              { return __hip_atomic_load(p, __ATOMIC_RELAXED, __HIP_MEMORY_SCOPE_AGENT); }
__device__ __forceinline__ unsigned xb_add(unsigned* p, unsigned v) { return __hip_atomic_fetch_add(p, v, __ATOMIC_RELAXED, __HIP_MEMORY_SCOPE_AGENT); }
__device__ __forceinline__ unsigned xb_xcc_id() { return (unsigned)__builtin_amdgcn_s_getreg((3 << 11) | 20) & 0xFu; }
#define XB_SPIN(cond, bar) do { unsigned _sp = 0; while (cond) { __builtin_amdgcn_s_sleep(1); \
    if ((++_sp & 255u) == 0u) { if (xb_ld(&(bar)[XB_TMO])) break; if (_sp > XB_SPIN_CAP) { atomicAdd(&(bar)[XB_TMO], 1u); break; } } } } while (0)
struct XcdBarrier { unsigned* bar; unsigned x; volatile LAS unsigned* st; };
__device__ __forceinline__ XcdBarrier xcd_barrier_post(unsigned* bar, volatile LAS unsigned* st) {
    XcdBarrier b; b.bar = bar; b.x = xb_xcc_id(); b.st = st;
    if (threadIdx.x == 0) (void)xb_add(&bar[XB_XCNT(b.x)], 1u);
    return b;
}
__device__ __forceinline__ void xcd_barrier_complete(unsigned* bar, unsigned x, unsigned& nloc, unsigned& nx) {
    const unsigned G = gridDim.x * gridDim.y * gridDim.z;
    unsigned sum, cnt, mine, sp = 0u;
    for (;;) {
        sum = 0u; cnt = 0u; mine = 0u;
#pragma unroll
        for (unsigned j = 0; j < 16; ++j) { const unsigned c = xb_ld(&bar[XB_XCNT(j)]); sum += c; cnt += (c > 0u) ? 1u : 0u; mine = (j == x) ? c : mine; }
        if (sum == G) break;
        __builtin_amdgcn_s_sleep(1);
        if ((++sp & 255u) == 0u) { if (xb_ld(&bar[XB_TMO])) break; if (sp > XB_SPIN_CAP) { atomicAdd(&bar[XB_TMO], 1u); break; } }
    }
    nloc = mine > 0u ? mine : 1u; nx = cnt > 0u ? cnt : 1u;
}
__device__ __forceinline__ void xcd_barrier(unsigned* bar, unsigned x, volatile LAS unsigned* st) {
    asm volatile("s_waitcnt vmcnt(0)" ::: "memory");
    __syncthreads();
    if (threadIdx.x == 0) {
        __builtin_amdgcn_s_waitcnt(0);
        unsigned nloc = st[0], nx = st[1];
        if (nloc == 0u) { xcd_barrier_complete(bar, x, nloc, nx); st[0] = nloc; st[1] = nx; }
        const unsigned old = xb_add(&bar[XB_XSUB(x)], 1u);
        const unsigned gen = old / nloc;
        if (old + 1u == (gen + 1u) * nloc) {
            __builtin_amdgcn_fence(__ATOMIC_RELEASE, "agent");
            asm volatile("s_waitcnt vmcnt(0)" ::: "memory");
            const unsigned og = xb_add(&bar[XB_TOP], 1u);
            const unsigned tg = og / nx;
            if (og + 1u == (tg + 1u) * nx) xb_add(&bar[XB_TOPGEN], 1u);
            else XB_SPIN(xb_ld(&bar[XB_TOPGEN]) == tg, bar);
            __builtin_amdgcn_fence(__ATOMIC_ACQUIRE, "agent");
            xb_add(&bar[XB_XGEN(x)], 1u);
            asm volatile("s_waitcnt vmcnt(0)" ::: "memory");
        } else {
            XB_SPIN(xb_ld(&bar[XB_XGEN(x)]) == gen, bar);
            __builtin_amdgcn_fence(__ATOMIC_ACQUIRE, "agent");
            asm volatile("s_waitcnt vmcnt(0)" ::: "memory");
        }
    }
    __syncthreads();
}

constexpr int PH_PER_LAYER = 9, N_PHASES = 1 + DEPTH * PH_PER_LAYER;

__global__ void __launch_bounds__(512, 2) fwd_kernel(Args Punused) {
    extern __shared__ __attribute__((aligned(16))) unsigned char lds_raw[];
    cg::grid_group grid = cg::this_grid();
    LAS unsigned char* ldsl = (LAS unsigned char*)lds_raw;
#define KP_DECL KArgs kp = (KArgs)__builtin_amdgcn_kernarg_segment_ptr(); asm volatile("" : "+s"(kp))
#define BST ((volatile LAS unsigned*)(ldsl + 131072))
    if (threadIdx.x < 4) BST[threadIdx.x] = 0u;
    __syncthreads();
#if MK_PER_PHASE_LAUNCH
    int lo, hi;
    { KP_DECL; lo = kp->ph_lo; hi = kp->ph_hi; }
#else
    constexpr int lo = 0, hi = N_PHASES;
    { KP_DECL; (void)xcd_barrier_post((unsigned*)(gptr(kp->ws) + WS_BAR), BST); }
#endif
#ifndef ONLY
#define ONLY -1
#endif
#define EN(n) (ONLY < 0 || ONLY == (n))
#define IN(k) (lo <= (k) && (k) < hi)
#define SYNC(k) do { if (IN((k) + 1)) { KP_DECL; xcd_barrier((unsigned*)(gptr(kp->ws) + WS_BAR), xb_xcc_id(), BST); } } while (0)
#define SYNC_CG(k) do { if (IN((k) + 1)) grid.sync(); } while (0)

    if (EN(0) && IN(0)) { KP_DECL; prologue(kp, lds_raw);
#if MK_PER_PHASE_LAUNCH
        SYNC_CG(0);
#else
        if (kp->ph_lo < 0) grid.sync();
        SYNC(0);
#endif
    }

#pragma unroll 1
    for (int l = 0; l < DEPTH; ++l) {
        const int p0 = 1 + l * PH_PER_LAYER;
        if (EN(1) && IN(p0 + 0)) {
            KP_DECL; unsigned char* ws = gptr(kp->ws); unsigned char* wl = ws + WS_W + (size_t)l * WL_SIZE;
            pg8::Gemm g{(const bf16_t*)(ws + WS_XB), (const bf16_t*)(wl + WL_IN), MROWS, ZP, DM, DM}; pg8::StaticOrder S; S.init(MROWS, ZP, (int)gridDim.x, (int)blockIdx.x);
            pg8::inv_prepass((LAS float*)(ldsl + pg8::LINV_OFF), (const float*)(ws + WS_RS), S);
            pg8::EpiScale<0> E{(bf16_t*)(ws + WS_Z), ZP, (const LAS float*)(ldsl + pg8::LINV_OFF), 17, 0};
            pg8::gemm_phase(ldsl, g, S, E);
            SYNC(p0 + 0);
        }
        if (EN(2) && IN(p0 + 1)) {
            KP_DECL; unsigned char* ws = gptr(kp->ws); const int G = gridDim.x;
            bf16_t* Z = (bf16_t*)(ws + WS_Z);
            for (int it = blockIdx.x; it < 512; it += G) {
                int item = it;
                if (G == 256) { const int c = it & 255, p = (c & 7) + 8 * (it >> 8); item = ((p >> 1) << 6) | ((c >> 3) << 1) | (p & 1); }
                attn_item(lds_raw, Z, (const f32x2*)(ws + WS_ROPE), gptr(kp->qn) + l * 64, gptr(kp->kn) + l * 64, gptr(kp->sinks) + l * 8, item);
            }
            for (int it = blockIdx.x; it < BATCH * NCH; it += G) m1_item4(lds_raw, Z, gptr(kp->gbias) + l * 8, (bf16_t*)(ws + WS_DC), (float*)(ws + WS_DN), (float*)(ws + WS_G), (float*)(ws + WS_ML), it);
            SYNC(p0 + 1);
        }
        if (EN(3) && IN(p0 + 2)) {
            KP_DECL; unsigned char* ws = gptr(kp->ws); const int G = gridDim.x;
            for (int it = blockIdx.x; it < 256; it += G) scan_item(lds_raw, (unsigned*)(ws + WS_DC), (float*)(ws + WS_DN), (const float*)(ws + WS_G), (const float*)(ws + WS_ML), (float*)(ws + WS_MP), it);
            SYNC(p0 + 2);
        }
        if (EN(4) && IN(p0 + 3)) {
            KP_DECL; unsigned char* ws = gptr(kp->ws); const int G = gridDim.x;
            for (int it = blockIdx.x; it < BATCH * NCH * 2; it += G) m3_item(lds_raw, (bf16_t*)(ws + WS_Z), gptr(kp->gbias) + l * 8, gptr(kp->hn) + l * 512, (const bf16_t*)(ws + WS_DC), (const float*)(ws + WS_DN), (const float*)(ws + WS_MP), it);
            SYNC(p0 + 3);
        }
        if (EN(5) && IN(p0 + 4)) {
            KP_DECL; unsigned char* ws = gptr(kp->ws); unsigned char* wl = ws + WS_W + (size_t)l * WL_SIZE; bf16_t* Z = (bf16_t*)(ws + WS_Z);
            pg8::Gemm g{Z + ZC_QA, (const bf16_t*)(wl + WL_AB), MROWS, DM, 512, ZP}; pg8::StaticOrder S; S.init(MROWS, DM, (int)gridDim.x, (int)blockIdx.x);
            pg8::EpiGate<0> E{(bf16_t*)(ws + WS_DC), Z, ZC_GA};
            pg8::gemm_phase(ldsl, g, S, E);
            __syncthreads();
        }
        if (EN(6) && IN(p0 + 5)) {
            KP_DECL; unsigned char* ws = gptr(kp->ws); unsigned char* wl = ws + WS_W + (size_t)l * WL_SIZE; bf16_t* Z = (bf16_t*)(ws + WS_Z);
            pg8::Gemm g{Z + ZC_VM, (const bf16_t*)(wl + WL_MB), MROWS, DM, 512, ZP}; pg8::StaticOrder S; S.init(MROWS, DM, (int)gridDim.x, (int)blockIdx.x);
            pg8::EpiGate<1> E{(bf16_t*)(ws + WS_DC), Z, ZC_GM};
            pg8::gemm_phase(ldsl, g, S, E);
            SYNC(p0 + 5);
        }
        if (EN(7) && IN(p0 + 6)) {
            KP_DECL; unsigned char* ws = gptr(kp->ws); unsigned char* wl = ws + WS_W + (size_t)l * WL_SIZE;
            pg8::Gemm g{(const bf16_t*)(ws + WS_DC), (const bf16_t*)(wl + WL_OUT), MROWS, DM, DM, DM}; pg8::StaticOrder S; S.init(MROWS, DM, (int)gridDim.x, (int)blockIdx.x);
            pg8::EpiRes<0> E{gptr(kp->out), (bf16_t*)(ws + WS_XB), (float*)(ws + WS_RS)};
            pg8::gemm_phase(ldsl, g, S, E);
            SYNC(p0 + 6);
        }
        if (EN(8) && IN(p0 + 7)) {
            KP_DECL; unsigned char* ws = gptr(kp->ws); unsigned char* wl = ws + WS_W + (size_t)l * WL_SIZE;
            pg8::Gemm g{(const bf16_t*)(ws + WS_XB), (const bf16_t*)(wl + WL_1), MROWS, DFF, DM, DM}; pg8::StaticOrder S; S.init(MROWS, DFF, (int)gridDim.x, (int)blockIdx.x);
            pg8::inv_prepass((LAS float*)(ldsl + pg8::LINV_OFF), (const float*)(ws + WS_RS), S);
            pg8::EpiScale<1> E{(bf16_t*)(ws + WS_Z), DFF, (const LAS float*)(ldsl + pg8::LINV_OFF), -1, 1};
            pg8::gemm_phase(ldsl, g, S, E);
            SYNC(p0 + 7);
        }
        if (EN(9) && IN(p0 + 8)) {
            KP_DECL; unsigned char* ws = gptr(kp->ws); unsigned char* wl = ws + WS_W + (size_t)l * WL_SIZE;
            pg8::Gemm g{(const bf16_t*)(ws + WS_Z), (const bf16_t*)(wl + WL_2), MROWS, DM, DFF, 64, 1, 1};     pg8::StaticOrder S; S.init(MROWS, DM, (int)gridDim.x, (int)blockIdx.x);
            if (l == DEPTH - 1) { pg8::EpiRes<1> E{gptr(kp->out), (bf16_t*)(ws + WS_XB), (float*)(ws + WS_RS)}; pg8::gemm_phase(ldsl, g, S, E); }
            else { pg8::EpiRes<0> E{gptr(kp->out), (bf16_t*)(ws + WS_XB), (float*)(ws + WS_RS)}; pg8::gemm_phase(ldsl, g, S, E); }
            SYNC(p0 + 8);
        }
    }
#undef IN
#undef SYNC
}

extern "C" void kernel_launch(void* const* d_in, const int* in_sizes, int n_in, void* d_out, int out_size, void* d_ws, size_t ws_size, hipStream_t stream) {
    static int grid = 0;
    if (grid == 0) {
        if (n_in != 14 || in_sizes[0] != MROWS * DM || out_size != MROWS * DM || ws_size < WS_END) {
            fprintf(stderr, "kernel_launch: unexpected shapes / workspace (n_in %d, in0 %d, out %d, ws %zu); nothing launched\n", n_in, n_in > 0 ? in_sizes[0] : -1, out_size, ws_size); grid = -1; return; }
        int dev = 0, cus = 0, per_cu = 0;
        hipGetDevice(&dev); hipDeviceGetAttribute(&cus, hipDeviceAttributeMultiprocessorCount, dev);
        if (hipFuncSetAttribute((const void*)fwd_kernel, hipFuncAttributeMaxDynamicSharedMemorySize, LDS_BYTES) != hipSuccess) { fprintf(stderr, "kernel_launch: hipFuncSetAttribute failed\n"); grid = -1; return; }
        if (hipOccupancyMaxActiveBlocksPerMultiprocessor(&per_cu, (const void*)fwd_kernel, 512, LDS_BYTES) != hipSuccess || per_cu < 1) { fprintf(stderr, "kernel_launch: occupancy query failed (%d)\n", per_cu); per_cu = 1; (void)hipGetLastError(); }
        grid = cus * (per_cu > 1 ? 1 : per_cu);
        if (grid <= 0) { grid = -1; return; }
    }
    if (grid < 0) return;
    Args a{};
    a.x = (const float*)d_in[0]; a.norm_mix = (const float*)d_in[1]; a.w_in = (const float*)d_in[2]; a.qn = (const float*)d_in[3]; a.kn = (const float*)d_in[4];
    a.sinks = (const float*)d_in[5]; a.gbias = (const float*)d_in[6]; a.hn = (const float*)d_in[7]; a.w_ab = (const float*)d_in[8]; a.w_mb = (const float*)d_in[9];
    a.w_out = (const float*)d_in[10]; a.norm_ffn = (const float*)d_in[11]; a.w1 = (const float*)d_in[12]; a.w2 = (const float*)d_in[13];
    a.out = (float*)d_out; a.ws = (unsigned char*)d_ws;
    for (int i = 0; i < 8; ++i) a.inv_freq[i] = (float)pow(500000.0, -(double)(2 * i) / 16.0);
#if MK_PER_PHASE_LAUNCH
    for (int p = 0; p < N_PHASES; ++p) {
        a.ph_lo = p; a.ph_hi = p + 1;
        hipLaunchKernelGGL(fwd_kernel, dim3(grid), dim3(512), LDS_BYTES, stream, a);
    }
#else
    a.ph_lo = 0; a.ph_hi = N_PHASES;
    if (hipMemsetAsync((char*)d_ws + WS_BAR, 0, 16384, stream) != hipSuccess) { fprintf(stderr, "kernel_launch: memset of barrier words failed\n"); return; }
    void* args[] = {&a};
    hipError_t e = hipLaunchCooperativeKernel((const void*)fwd_kernel, dim3(grid), dim3(512), args, LDS_BYTES, stream);
    if (e != hipSuccess) fprintf(stderr, "cooperative launch failed: %s (grid %d)\n", hipGetErrorString(e), grid);
#endif
}
```
